# Optimizing an MI355X kernel written in HIP

```python
import math
import jax, jax.numpy as jnp
from jax import lax
import numpy as np

D_MODEL = 2048
BATCH = 4
SEQ = 2048
DEPTH = 4

MIX_WIDTH = D_MODEL
SSM_WIDTH = D_MODEL // 2
CONV_WIDTH = MIX_WIDTH - SSM_WIDTH
SSM_CH_PER_GROUP = 16
SSM_GROUPS = SSM_WIDTH // SSM_CH_PER_GROUP
SSM_STATE = 64
IN_WIDTH = SSM_WIDTH + 2 * CONV_WIDTH
CONV_K = 31
N_EXPERT_GROUPS = 4
EXPERTS_PER_GROUP = 8
N_EXPERTS = N_EXPERT_GROUPS * EXPERTS_PER_GROUP
EXPERT_TOP_K = 2
EXPERT_HIDDEN = D_MODEL // 8
PLE_DIM = 256
DEEPNORM_ALPHA = (2 * DEPTH) ** 0.25
DEEPNORM_BETA = (8 * DEPTH) ** -0.25
LN_EPS = 1e-5
LAMBDA_RE_MAX = -1e-4
DT_MIN = 1e-3
DT_MAX = 1e-1

kernel_name = 'hymba_s5_conformer_hmoe_deepnorm'


def layer_norm(x, g, b):
    xf = x.astype(jnp.float32)
    mu = jnp.mean(xf, axis=-1, keepdims=True)
    xc = xf - mu
    var = jnp.mean(xc * xc, axis=-1, keepdims=True)
    y = xc * lax.rsqrt(var + LN_EPS) * g.astype(jnp.float32) + b.astype(jnp.float32)
    return y.astype(x.dtype)


def s5_group(u, lam_re, lam_im, log_dt, b_re, b_im, c_re, c_im, d_skip, w_glu, b_glu):
    bsz, seqlen, _ = u.shape
    f32 = jnp.float32
    uf = u.astype(f32).reshape(bsz, seqlen, SSM_GROUPS, SSM_CH_PER_GROUP)
    lam = lax.complex(jnp.minimum(lam_re.astype(f32), LAMBDA_RE_MAX), lam_im.astype(f32))
    dt = jnp.exp(log_dt.astype(f32))[:, None]
    lam_bar = jnp.exp(lam * dt)
    b_c = lax.complex(b_re.astype(f32), b_im.astype(f32))
    b_bar = ((lam_bar - 1.0) / lam)[..., None] * b_c
    bu = jnp.einsum('blgh,gph->blgp', uf.astype(jnp.complex64), b_bar)
    a = jnp.broadcast_to(lam_bar[None, None], (1, seqlen, SSM_GROUPS, SSM_STATE))

    def combine(left, right):
        a1, s1 = left
        a2, s2 = right
        return a1 * a2, a2 * s1 + s2

    _, states = lax.associative_scan(combine, (a, bu), axis=1)
    c_c = lax.complex(c_re.astype(f32), c_im.astype(f32))
    y = jnp.einsum('blgp,ghp->blgh', states, c_c).real
    y = y + d_skip.astype(f32).reshape(SSM_GROUPS, SSM_CH_PER_GROUP) * uf
    y = y.reshape(bsz, seqlen, SSM_WIDTH)
    z = jax.nn.gelu(y)
    out = z * jax.nn.sigmoid(z @ w_glu.astype(f32) + b_glu.astype(f32))
    return out.astype(u.dtype)


def conformer_conv_group(v, g, w_dw, b_dw, ln_g, ln_b):
    h = v * jax.nn.sigmoid(g)
    h = lax.conv_general_dilated(h, w_dw[:, None, :], window_strides=(1,),
                                 padding=[(CONV_K - 1, 0)],
                                 dimension_numbers=('NWC', 'WIO', 'NWC'),
                                 feature_group_count=CONV_WIDTH) + b_dw
    h = layer_norm(h, ln_g, ln_b)
    return jax.nn.silu(h)


def hierarchical_moe(h, w_rg, b_rg, w_re, b_re, w_gate, w_up, w_down):
    bsz, seqlen, dm = h.shape
    n_tok = bsz * seqlen
    t = h.reshape(n_tok, dm)
    g_prob = jax.nn.softmax((t @ w_rg + b_rg).astype(jnp.float32), axis=-1)
    g_p, g_idx = lax.top_k(g_prob, 1)
    e_logits = (t @ w_re + b_re).astype(jnp.float32).reshape(n_tok, N_EXPERT_GROUPS, EXPERTS_PER_GROUP)
    sel = jnp.broadcast_to(g_idx[:, :, None], (n_tok, 1, EXPERTS_PER_GROUP))
    e_sel = jnp.take_along_axis(e_logits, sel, axis=1)[:, 0]
    e_val, e_idx = lax.top_k(e_sel, EXPERT_TOP_K)
    e_w = jax.nn.softmax(e_val, axis=-1) * g_p
    expert_id = g_idx * EXPERTS_PER_GROUP + e_idx
    combine_w = jnp.sum(jax.nn.one_hot(expert_id, N_EXPERTS, dtype=jnp.float32) * e_w[..., None], axis=1)
    gate = jnp.einsum('nd,edf->nef', t, w_gate)
    up = jnp.einsum('nd,edf->nef', t, w_up)
    act = jax.nn.silu(gate) * up * combine_w[..., None].astype(t.dtype)
    out = jnp.einsum('nef,efd->nd', act, w_down)
    return out.reshape(bsz, seqlen, dm)


def setup_inputs(seed: int = 0) -> dict:
    key = jax.random.key(seed)
    ks = jax.random.split(key, 36)
    f32 = jnp.float32

    def nrm(k, shape, scale):
        return scale * jax.random.normal(k, shape, f32)

    L, G, P, CH = DEPTH, SSM_GROUPS, SSM_STATE, SSM_CH_PER_GROUP
    return {
        'x': nrm(ks[0], (BATCH, SEQ, D_MODEL), 1.0),
        'p': nrm(ks[1], (DEPTH, BATCH, SEQ, PLE_DIM), 1.0),
        'w_in': nrm(ks[2], (L, D_MODEL, IN_WIDTH), D_MODEL ** -0.5),
        'b_in': nrm(ks[3], (L, IN_WIDTH), 0.01),
        'lam_re': -0.5 + nrm(ks[4], (L, G, P), 0.01),
        'lam_im': jnp.pi * jnp.arange(P, dtype=f32)[None, None, :] + nrm(ks[5], (L, G, P), 0.01),
        'log_dt': jax.random.uniform(ks[6], (L, G), f32, math.log(DT_MIN), math.log(DT_MAX)),
        'ssm_b_re': nrm(ks[7], (L, G, P, CH), (2 * CH) ** -0.5),
        'ssm_b_im': nrm(ks[8], (L, G, P, CH), (2 * CH) ** -0.5),
        'ssm_c_re': nrm(ks[9], (L, G, CH, P), (2 * P) ** -0.5),
        'ssm_c_im': nrm(ks[10], (L, G, CH, P), (2 * P) ** -0.5),
        'ssm_d': nrm(ks[11], (L, SSM_WIDTH), 1.0),
        'w_glu': nrm(ks[12], (L, SSM_WIDTH, SSM_WIDTH), SSM_WIDTH ** -0.5),
        'b_glu': nrm(ks[13], (L, SSM_WIDTH), 0.01),
        'w_dw': nrm(ks[14], (L, CONV_K, CONV_WIDTH), CONV_K ** -0.5),
        'b_dw': nrm(ks[15], (L, CONV_WIDTH), 0.01),
        'conv_ln_g': 1.0 + nrm(ks[16], (L, CONV_WIDTH), 0.01),
        'conv_ln_b': nrm(ks[17], (L, CONV_WIDTH), 0.01),
        'w_o': nrm(ks[18], (L, MIX_WIDTH, D_MODEL), DEEPNORM_BETA * MIX_WIDTH ** -0.5),
        'b_o': nrm(ks[19], (L, D_MODEL), 0.01),
        'ln1_g': 1.0 + nrm(ks[20], (L, D_MODEL), 0.01),
        'ln1_b': nrm(ks[21], (L, D_MODEL), 0.01),
        'w_rg': nrm(ks[22], (L, D_MODEL, N_EXPERT_GROUPS), D_MODEL ** -0.5),
        'b_rg': nrm(ks[23], (L, N_EXPERT_GROUPS), 0.01),
        'w_re': nrm(ks[24], (L, D_MODEL, N_EXPERTS), D_MODEL ** -0.5),
        'b_re': nrm(ks[25], (L, N_EXPERTS), 0.01),
        'w_gate': nrm(ks[26], (L, N_EXPERTS, D_MODEL, EXPERT_HIDDEN), D_MODEL ** -0.5),
        'w_up': nrm(ks[27], (L, N_EXPERTS, D_MODEL, EXPERT_HIDDEN), D_MODEL ** -0.5),
        'w_down': nrm(ks[28], (L, N_EXPERTS, EXPERT_HIDDEN, D_MODEL), DEEPNORM_BETA * EXPERT_HIDDEN ** -0.5),
        'ln2_g': 1.0 + nrm(ks[29], (L, D_MODEL), 0.01),
        'ln2_b': nrm(ks[30], (L, D_MODEL), 0.01),
        'w_p': nrm(ks[31], (L, PLE_DIM, D_MODEL), DEEPNORM_BETA * PLE_DIM ** -0.5),
        'w_pg': nrm(ks[32], (L, D_MODEL, D_MODEL), D_MODEL ** -0.5),
        'b_pg': nrm(ks[33], (L, D_MODEL), 0.01),
        'ln3_g': 1.0 + nrm(ks[34], (L, D_MODEL), 0.01),
        'ln3_b': nrm(ks[35], (L, D_MODEL), 0.01),
    }


def reference(x, p, w_in, b_in, lam_re, lam_im, log_dt, ssm_b_re, ssm_b_im, ssm_c_re, ssm_c_im,
              ssm_d, w_glu, b_glu, w_dw, b_dw, conv_ln_g, conv_ln_b, w_o, b_o, ln1_g, ln1_b,
              w_rg, b_rg, w_re, b_re, w_gate, w_up, w_down, ln2_g, ln2_b, w_p, w_pg, b_pg,
              ln3_g, ln3_b):
    for i in range(DEPTH):
        z = x @ w_in[i] + b_in[i]
        u_ssm = z[..., :SSM_WIDTH]
        v_conv = z[..., SSM_WIDTH:SSM_WIDTH + CONV_WIDTH]
        g_conv = z[..., SSM_WIDTH + CONV_WIDTH:]
        y_ssm = s5_group(u_ssm, lam_re[i], lam_im[i], log_dt[i], ssm_b_re[i], ssm_b_im[i],
                         ssm_c_re[i], ssm_c_im[i], ssm_d[i], w_glu[i], b_glu[i])
        y_conv = conformer_conv_group(v_conv, g_conv, w_dw[i], b_dw[i], conv_ln_g[i], conv_ln_b[i])
        y = jnp.concatenate([y_ssm, y_conv], axis=-1) @ w_o[i] + b_o[i]
        h = layer_norm(DEEPNORM_ALPHA * x + y, ln1_g[i], ln1_b[i])
        m = hierarchical_moe(h, w_rg[i], b_rg[i], w_re[i], b_re[i], w_gate[i], w_up[i], w_down[i])
        h = layer_norm(DEEPNORM_ALPHA * h + m, ln2_g[i], ln2_b[i])
        e = (p[i] @ w_p[i]) * jax.nn.sigmoid(h @ w_pg[i] + b_pg[i])
        x = layer_norm(DEEPNORM_ALPHA * h + e, ln3_g[i], ln3_b[i])
    return x
```

```cpp
#include <hip/hip_runtime.h>
#include <cstdio>
#include <cstdint>

#ifndef MK_SINGLE
#define MK_SINGLE 1
#endif
#ifndef DBG_CHECK
#define DBG_CHECK 0
#endif

namespace pg8 {
#define PG8_LAS __attribute__((address_space(3)))
typedef unsigned short bf16_t;
typedef short bf16x8 __attribute__((ext_vector_type(8)));
typedef float f32x4 __attribute__((ext_vector_type(4)));
typedef unsigned u32x4 __attribute__((ext_vector_type(4)));
constexpr int BM = 256, BK = 64, HALF = 128, HTB = HALF * BK * 2, STAGE_BYTES = 8 * HTB, NXCD = 8, WGM = 8;

__host__ __device__ __forceinline__ int lds_byte(int r, int c) { const int st = (r >> 4) * 2 + (c >> 5), rr = r & 15, cc = c & 31, ob = rr * 64 + cc * 2; return st * 1024 + (ob ^ (((ob >> 9) & 1) << 5)); }
__host__ __device__ __forceinline__ void stage_rc(int b, int& R, int& C) { const int st = b / 1024, sb = b % 1024, swz = sb ^ (((sb >> 9) & 1) << 5); R = (st >> 1) * 16 + swz / 64; C = (st & 1) * 32 + (swz % 64) / 2; }
__host__ __device__ __forceinline__ int perm32(int rho) { const int n = rho >> 4, i = rho & 15; return 8 * (i >> 2) + 4 * n + (i & 3); }

struct Unit { int pm, pn, pc; };
struct Gemm { const bf16_t* A; const bf16_t* Bt; int M, N, K; };

struct StaticOrder {
    int nM, nN, nwg, G, c;
    __host__ __device__ void init(int M, int N, int G_, int c_) { nM = M / BM; nN = N / BM; nwg = nM * nN; G = G_; c = c_; }
    __host__ __device__ bool next(int i, Unit& u) const {
        const long L = (long)i * G + c; if (L >= nwg) return false;
        int wgid = (int)L; { const int q = nwg / NXCD, r = nwg % NXCD, xcd = wgid % NXCD, off = wgid / NXCD; wgid = (xcd < r ? xcd * (q + 1) : r * (q + 1) + (xcd - r) * q) + off; }
        const int nig = WGM * nN, gid = wgid / nig, fm = gid * WGM, gsz = (nM - fm) < WGM ? (nM - fm) : WGM;
        u.pm = fm + ((wgid % nig) % gsz); u.pn = (wgid % nig) / gsz; u.pc = u.pn; return true;
    }
    __device__ __forceinline__ void a_ready(const Unit&) const {}
    __device__ __forceinline__ void done(const Unit&) const {}
};
struct MoeOrder {
    const int* te; int ntiles, NJ, G, c;
    __device__ bool next(int i, Unit& u) const {
        const long L = (long)i * G + c; if (L >= (long)ntiles * NJ) return false;
        const int tile = (int)L / NJ, j = (int)L % NJ; const int e = te[tile];
        u.pm = tile; u.pn = e * NJ + j; u.pc = j; return true;
    }
    __device__ __forceinline__ void a_ready(const Unit&) const {}
    __device__ __forceinline__ void done(const Unit&) const {}
};

__device__ __forceinline__ unsigned cvt_pk_bf16(float lo, float hi) { unsigned r; asm volatile("v_cvt_pk_bf16_f32 %0, %1, %2" : "=v"(r) : "v"(lo), "v"(hi)); return r; }

template <class Epi, class Sched, bool ALIGN_EPI = false, bool SP2 = false>
__device__ __forceinline__ void gemm_phase(PG8_LAS unsigned char* lds, const Gemm g, const Sched& S, const Epi& E, int tid) {
    asm volatile("" : "+v"(tid));
    const int wid = __builtin_amdgcn_readfirstlane(tid >> 6), lane = tid & 63, wr = wid >> 2, wc = wid & 3, fr = lane & 15, fq = lane >> 4;
    const int K = g.K, nt = K / BK;
    unsigned voffA[2], voffB[2];
#pragma unroll
    for (int i = 0; i < 2; ++i) { int R, C; stage_rc(tid * 16 + i * 8192, R, C); const int Rb = Epi::PERM ? ((R & ~31) + perm32(R & 31)) : R;
        voffA[i] = (unsigned)(R * K + C) * 2u; voffB[i] = (unsigned)(Rb * K + C) * 2u; }
    const size_t kstep = (size_t)(BK * 2);
    const size_t hstep = (size_t)HALF * K * 2;
    const size_t tstep = 2 * hstep;
    const unsigned ldsw = (unsigned)wid * 1024u;
    const int aoff = lds_byte(wr * 64 + fr, fq * 8), boff = lds_byte(wc * 32 + fr, fq * 8);
#define PG8_SA(b, h) (((b) * 2 + (h)) * HTB)
#define PG8_SB(b, h) ((4 + (b) * 2 + (h)) * HTB)
#define PG8_STAGE(bufoff, gbase, voff) do { _Pragma("unroll") for (int _i = 0; _i < 2; ++_i) \
        __builtin_amdgcn_global_load_lds((const unsigned*)((const char*)(gbase) + (voff)[_i]), (PG8_LAS unsigned*)(lds + (bufoff) + ldsw + _i * 8192), 16, 0, 0); } while (0)
#define PG8_LDA(dst, b, h) do { _Pragma("unroll") for (int m = 0; m < 4; ++m) _Pragma("unroll") for (int k = 0; k < 2; ++k) dst[m][k] = *(const PG8_LAS bf16x8*)(lds + PG8_SA(b, h) + aoff + m * 2048 + k * 1024); } while (0)
#define PG8_LDB(dst, b, h) do { _Pragma("unroll") for (int n = 0; n < 2; ++n) _Pragma("unroll") for (int k = 0; k < 2; ++k) dst[n][k] = *(const PG8_LAS bf16x8*)(lds + PG8_SB(b, h) + boff + n * 2048 + k * 1024); } while (0)
#define PG8_MMA(ai, bj, At, Bt) do { __builtin_amdgcn_s_setprio(1); _Pragma("unroll") for (int m = 0; m < 4; ++m) _Pragma("unroll") for (int n = 0; n < 2; ++n) _Pragma("unroll") for (int k = 0; k < 2; ++k) \
        acc[ai][bj][m][n] = __builtin_amdgcn_mfma_f32_16x16x32_bf16(Bt[n][k], At[m][k], acc[ai][bj][m][n], 0, 0, 0); __builtin_amdgcn_s_setprio(0); } while (0)
#define PG8_WAIT_V(n) asm volatile("s_waitcnt vmcnt(" #n ")" ::: "memory")
#define PG8_WAIT_L(n) asm volatile("s_waitcnt lgkmcnt(" #n ")" ::: "memory")
#define PG8_BAR __builtin_amdgcn_s_barrier()
#define PG8_SCHED __builtin_amdgcn_sched_barrier(0)
    Unit cur, nxt; int ui = 0;
    if (!S.next(0, cur)) return;
    f32x4 acc[2][2][4][2];
#pragma unroll
    for (int a = 0; a < 2; ++a)
#pragma unroll
        for (int b = 0; b < 2; ++b)
#pragma unroll
            for (int m = 0; m < 4; ++m)
#pragma unroll
                for (int n = 0; n < 2; ++n) acc[a][b][m][n] = (f32x4){0.f, 0.f, 0.f, 0.f};
    bf16x8 At[4][2], B0[2][2], B1[2][2];
    const char* cA = (const char*)g.A + (size_t)cur.pm * tstep; const char* cB = (const char*)g.Bt + (size_t)cur.pn * tstep;
    S.a_ready(cur);
    if constexpr (SP2) {
        PG8_STAGE(PG8_SB(0, 0), cB, voffB); PG8_STAGE(PG8_SB(0, 1), cB + hstep, voffB); PG8_STAGE(PG8_SA(0, 0), cA, voffA); PG8_STAGE(PG8_SA(0, 1), cA + hstep, voffA);
        if (wr == 1) PG8_BAR;
        PG8_WAIT_V(2); PG8_BAR;
        PG8_STAGE(PG8_SB(1, 0), cB + kstep, voffB); PG8_STAGE(PG8_SA(1, 0), cA + kstep, voffA); PG8_STAGE(PG8_SB(1, 1), cB + hstep + kstep, voffB);
        PG8_WAIT_V(6); PG8_BAR;
    } else {
        PG8_STAGE(PG8_SB(0, 0), cB, voffB); PG8_STAGE(PG8_SA(0, 0), cA, voffA); PG8_STAGE(PG8_SB(0, 1), cB + hstep, voffB); PG8_STAGE(PG8_SA(0, 1), cA + hstep, voffA);
        if (wr == 1) PG8_BAR;
        PG8_WAIT_V(4); PG8_BAR;
        PG8_STAGE(PG8_SB(1, 0), cB + kstep, voffB); PG8_STAGE(PG8_SA(1, 0), cA + kstep, voffA); PG8_STAGE(PG8_SB(1, 1), cB + hstep + kstep, voffB);
        PG8_WAIT_V(6); PG8_BAR;
    }
    for (;;) {
        const bool has_next = S.next(ui + 1, nxt);
        const char* nA = has_next ? (const char*)g.A + (size_t)nxt.pm * tstep : cA; const char* nB = has_next ? (const char*)g.Bt + (size_t)nxt.pn * tstep : cB;
        for (int t = 0; t < nt; t += 2) {
            const bool last = (t == nt - 2);
            const char* a1 = cA + (size_t)(t + 1) * kstep;
            const char* a2 = last ? nA : cA + (size_t)(t + 2) * kstep; const char* b2 = last ? nB : cB + (size_t)(t + 2) * kstep;
            const char* a3 = a2 + kstep; const char* b3 = b2 + kstep;
            if (last && has_next) S.a_ready(nxt);
            if constexpr (SP2) {
            PG8_LDB(B0, 0, 0); PG8_LDB(B1, 0, 1); PG8_SCHED; PG8_LDA(At, 0, 0); PG8_STAGE(PG8_SA(1, 1), a1 + hstep, voffA);
            PG8_WAIT_V(8); PG8_WAIT_L(0); PG8_BAR; PG8_MMA(0, 0, At, B0); PG8_MMA(0, 1, At, B1); PG8_BAR; PG8_SCHED;
            PG8_LDA(At, 0, 1); PG8_STAGE(PG8_SB(0, 0), b2, voffB); PG8_STAGE(PG8_SB(0, 1), b2 + hstep, voffB); PG8_STAGE(PG8_SA(0, 0), a2, voffA);
            PG8_WAIT_V(8); PG8_WAIT_L(0); PG8_BAR; PG8_MMA(1, 0, At, B0); PG8_MMA(1, 1, At, B1); PG8_BAR; PG8_SCHED;
            PG8_LDB(B0, 1, 0); PG8_LDB(B1, 1, 1); PG8_SCHED; PG8_LDA(At, 1, 0); PG8_STAGE(PG8_SA(0, 1), a2 + hstep, voffA);
            PG8_WAIT_V(8); PG8_WAIT_L(0); PG8_BAR; PG8_MMA(0, 0, At, B0); PG8_MMA(0, 1, At, B1); PG8_BAR; PG8_SCHED;
            PG8_LDA(At, 1, 1); PG8_STAGE(PG8_SB(1, 0), b3, voffB); PG8_STAGE(PG8_SB(1, 1), b3 + hstep, voffB); PG8_STAGE(PG8_SA(1, 0), a3, voffA);
            PG8_WAIT_V(8); PG8_WAIT_L(0); PG8_BAR; PG8_MMA(1, 0, At, B0); PG8_MMA(1, 1, At, B1); PG8_BAR; PG8_SCHED;
            } else {
            PG8_LDB(B0, 0, 0); PG8_SCHED; PG8_LDA(At, 0, 0); PG8_STAGE(PG8_SA(1, 1), a1 + hstep, voffA);
            PG8_WAIT_L(8); PG8_BAR; PG8_WAIT_L(0); PG8_MMA(0, 0, At, B0); PG8_BAR; PG8_SCHED;
            PG8_LDB(B1, 0, 1); PG8_STAGE(PG8_SB(0, 0), b2, voffB);
            PG8_BAR; PG8_WAIT_L(0); PG8_MMA(0, 1, At, B1); PG8_BAR;
            PG8_LDA(At, 0, 1); PG8_STAGE(PG8_SA(0, 0), a2, voffA);
            PG8_BAR; PG8_WAIT_L(0); PG8_MMA(1, 0, At, B0); PG8_BAR; PG8_SCHED;
            PG8_STAGE(PG8_SB(0, 1), b2 + hstep, voffB);
            PG8_WAIT_V(6); PG8_BAR; PG8_MMA(1, 1, At, B1); PG8_BAR;
            PG8_LDB(B0, 1, 0); PG8_SCHED; PG8_LDA(At, 1, 0); PG8_STAGE(PG8_SA(0, 1), a2 + hstep, voffA);
            PG8_WAIT_L(8); PG8_BAR; PG8_WAIT_L(0); PG8_MMA(0, 0, At, B0); PG8_BAR; PG8_SCHED;
            PG8_LDB(B1, 1, 1); PG8_STAGE(PG8_SB(1, 0), b3, voffB);
            PG8_BAR; PG8_WAIT_L(0); PG8_MMA(0, 1, At, B1); PG8_BAR;
            PG8_LDA(At, 1, 1); PG8_STAGE(PG8_SA(1, 0), a3, voffA);
            PG8_BAR; PG8_WAIT_L(0); PG8_MMA(1, 0, At, B0); PG8_BAR; PG8_SCHED;
            PG8_STAGE(PG8_SB(1, 1), b3 + hstep, voffB);
            PG8_WAIT_V(6); PG8_BAR; PG8_MMA(1, 1, At, B1); PG8_BAR;
            }
        }
        if constexpr (ALIGN_EPI) { if (wr == 0) PG8_BAR; }
        E(acc, cur, wr, wc, fr, fq); S.done(cur);
        if (!has_next) break;
#pragma unroll
        for (int a = 0; a < 2; ++a)
#pragma unroll
            for (int b = 0; b < 2; ++b)
#pragma unroll
                for (int m = 0; m < 4; ++m)
#pragma unroll
                    for (int n = 0; n < 2; ++n) acc[a][b][m][n] = (f32x4){0.f, 0.f, 0.f, 0.f};
        cur = nxt; cA = nA; cB = nB; ++ui;
        if constexpr (ALIGN_EPI) { if (wr == 1) PG8_BAR; }
    }
    PG8_WAIT_V(0);
    if constexpr (!ALIGN_EPI) { if (wr == 0) PG8_BAR; }
    PG8_BAR;
#undef PG8_SA
#undef PG8_SB
#undef PG8_STAGE
#undef PG8_LDA
#undef PG8_LDB
#undef PG8_MMA
#undef PG8_WAIT_V
#undef PG8_WAIT_L
#undef PG8_BAR
#undef PG8_SCHED
}
}

constexpr int NWAVES = 8;
constexpr int D_MODEL = 2048, BATCH = 4, SEQ = 2048, DEPTH = 4, NTOK = BATCH * SEQ;
constexpr int SSMW = 1024, CONVW = 1024, NGRP = 64, CH = 16, NST = 64, INW = 3072, CONV_K = 31;
constexpr int NEG = 4, EPG = 8, NEXP = 32, EH = 256, PLE = 256;
constexpr int SROWS = 24576;
constexpr int MAXTILES = SROWS / 256;
constexpr float ALPHA = 1.681792830507429f;
constexpr float LN_EPS = 1e-5f;

constexpr int PH_PER_LAYER = 11, NPHASES = 1 + PH_PER_LAYER * DEPTH;

constexpr size_t MiB = 1u << 20;
constexpr size_t WS_CTL = 0, CTL_ZERO_BYTES = 1 * MiB;
constexpr size_t WS_W0 = 1 * MiB, W_LAYER = 128 * MiB;
constexpr size_t WO_IN = 0, WO_GLU = 12 * MiB, WO_O = 14 * MiB, WO_GU = 22 * MiB, WO_D = 86 * MiB, WO_PG = 118 * MiB, WO_P = 126 * MiB, WO_R = 127 * MiB;
constexpr size_t WS_ACT = WS_W0 + DEPTH * W_LAYER;
constexpr size_t WS_XB = WS_ACT, WS_PB = WS_XB + 32 * MiB, WS_U = WS_PB + 16 * MiB, WS_HC = WS_U + 16 * MiB, WS_Z = WS_HC + 16 * MiB, WS_MIX = WS_Z + 16 * MiB,
                 WS_V = WS_MIX + 32 * MiB, WS_H1 = WS_V + 64 * MiB, WS_XS = WS_H1 + 32 * MiB, WS_HS = WS_XS + 96 * MiB, WS_H2 = WS_HS + 12 * MiB, WS_E1 = WS_H2 + 32 * MiB,
                 WS_ROWW = WS_E1 + 32 * MiB, WS_TOK = WS_ROWW + 1 * MiB, WS_END = WS_TOK + 1 * MiB;
constexpr int CW_TMO = 0, CW_BAR = 4096, CW_CNT = 8192  , CW_DBG = 12288  , CW_NT = 16384  , CW_TE = 20480  ;

constexpr int RING_BYTES = 139264;
constexpr int MISC_OFF = RING_BYTES;
constexpr int LDS_BYTES = 147456;

#define GAS __attribute__((address_space(1)))
#define LAS __attribute__((address_space(3)))
typedef unsigned short bf16;
typedef unsigned v4u __attribute__((ext_vector_type(4)));
typedef unsigned v2u __attribute__((ext_vector_type(2)));
typedef float f32x4 __attribute__((ext_vector_type(4)));
typedef float f32x2 __attribute__((ext_vector_type(2)));
typedef short bf16x8 __attribute__((ext_vector_type(8)));
#define LDS_WAIT() asm volatile("s_waitcnt lgkmcnt(0)" ::: "memory")
#define VM_WAIT() asm volatile("s_waitcnt vmcnt(0)" ::: "memory")
__device__ __forceinline__ float bflo(unsigned w) { return __uint_as_float(w << 16); }
__device__ __forceinline__ float bfhi(unsigned w) { return __uint_as_float(w & 0xffff0000u); }
__device__ __forceinline__ float bf2f(bf16 b) { return __uint_as_float((unsigned)b << 16); }
__device__ __forceinline__ unsigned f2bf(float f) { unsigned u = __float_as_uint(f); return (u + 0x7fffu + ((u >> 16) & 1u)) >> 16; }
__device__ __forceinline__ unsigned pk2(float lo, float hi) { return pg8::cvt_pk_bf16(lo, hi); }
__device__ __forceinline__ float sigm(float x) { return __builtin_amdgcn_rcpf(1.f + __expf(-x)); }
__device__ __forceinline__ float silu_f(float x) { return x * sigm(x); }
__device__ __forceinline__ float gelu_tanh(float y) { const float x = 0.7978845608028654f * (y + 0.044715f * y * y * y); const float t = 1.f - 2.f * __builtin_amdgcn_rcpf(1.f + __expf(2.f * x)); return 0.5f * y * (1.f + t); }
__device__ __forceinline__ void unpack8(const v4u w, float (&f)[8]) { f[0] = bflo(w.x); f[1] = bfhi(w.x); f[2] = bflo(w.y); f[3] = bfhi(w.y); f[4] = bflo(w.z); f[5] = bfhi(w.z); f[6] = bflo(w.w); f[7] = bfhi(w.w); }
__device__ __forceinline__ v4u pack8(const float (&f)[8]) { v4u w; w.x = pk2(f[0], f[1]); w.y = pk2(f[2], f[3]); w.z = pk2(f[4], f[5]); w.w = pk2(f[6], f[7]); return w; }
template <int X> __device__ __forceinline__ float swz_xor(float v) { return __int_as_float(__builtin_amdgcn_ds_swizzle(__float_as_int(v), (X << 10) | 0x1f)); }
__device__ __forceinline__ float wave_sum(float v) {
    v += swz_xor<1>(v); v += swz_xor<2>(v); v += swz_xor<4>(v); v += swz_xor<8>(v); v += swz_xor<16>(v);
    return __int_as_float(__builtin_amdgcn_readlane(__float_as_int(v), 0)) + __int_as_float(__builtin_amdgcn_readlane(__float_as_int(v), 32));
}

#define XB_TMO      128
#define XB_XCNT(j)  (256  + 64 * (j))
#define XB_XSUB(j)  (1280 + 64 * (j))
#define XB_XGEN(j)  (2304 + 64 * (j))
#define XB_TOP      3328
#define XB_TOPGEN   3392
#define XCD_BAR_WORDS 3456
#define XB_SPIN_CAP (1u << 18)
__device__ __forceinline__ unsigned xb_ld(unsigned* p)              { return __hip_atomic_load(p, __ATOMIC_RELAXED, __HIP_MEMORY_SCOPE_AGENT); }
__device__ __forceinline__ unsigned xb_add(unsigned* p, unsigned v) { return __hip_atomic_fetch_add(p, v, __ATOMIC_RELAXED, __HIP_MEMORY_SCOPE_AGENT); }
__device__ __forceinline__ unsigned xb_xcc_id() { return (unsigned)__builtin_amdgcn_s_getreg((3 << 11) | 20) & 0xFu; }
#define XB_SPIN(cond, bar) do { unsigned _sp = 0; while (cond) { __builtin_amdgcn_s_sleep(1); \
    if ((++_sp & 255u) == 0u) { if (xb_ld(&(bar)[XB_TMO])) break; if (_sp > XB_SPIN_CAP) { atomicAdd(&(bar)[XB_TMO], 1u); break; } } } } while (0)
struct XcdBarrier { unsigned* bar; unsigned x; volatile LAS unsigned* st; };
__device__ __forceinline__ XcdBarrier xcd_barrier_post(unsigned* bar, volatile LAS unsigned* st) {
    XcdBarrier b; b.bar = bar; b.x = xb_xcc_id(); b.st = st;
    if (threadIdx.x == 0) (void)xb_add(&bar[XB_XCNT(b.x)], 1u);
    return b;
}
__device__ __forceinline__ void xcd_barrier_complete(unsigned* bar, unsigned x, unsigned& nloc, unsigned& nx) {
    const unsigned G = gridDim.x * gridDim.y * gridDim.z;
    unsigned sum, cnt, mine, sp = 0u;
    for (;;) {
        sum = 0u; cnt = 0u; mine = 0u;
#pragma unroll
        for (unsigned j = 0; j < 16; ++j) { const unsigned c = xb_ld(&bar[XB_XCNT(j)]); sum += c; cnt += (c > 0u) ? 1u : 0u; mine = (j == x) ? c : mine; }
        if (sum == G) break;
        __builtin_amdgcn_s_sleep(1);
        if ((++sp & 255u) == 0u) { if (xb_ld(&bar[XB_TMO])) break; if (sp > XB_SPIN_CAP) { atomicAdd(&bar[XB_TMO], 1u); break; } }
    }
    nloc = mine > 0u ? mine : 1u; nx = cnt > 0u ? cnt : 1u;
}
__device__ __forceinline__ void xcd_barrier(const XcdBarrier& b) {
    asm volatile("s_waitcnt vmcnt(0)" ::: "memory");
    __syncthreads();
    if (threadIdx.x == 0) {
        unsigned* bar = b.bar;
        __builtin_amdgcn_s_waitcnt(0);
        unsigned nloc = b.st[0], nx = b.st[1];
        if (nloc == 0u) { xcd_barrier_complete(bar, b.x, nloc, nx); b.st[0] = nloc; b.st[1] = nx; }
        const unsigned old = xb_add(&bar[XB_XSUB(b.x)], 1u);
        const unsigned gen = old / nloc;
        if (old + 1u == (gen + 1u) * nloc) {
            __builtin_amdgcn_fence(__ATOMIC_RELEASE, "agent");
            asm volatile("s_waitcnt vmcnt(0)" ::: "memory");
            const unsigned og = xb_add(&bar[XB_TOP], 1u);
            const unsigned tg = og / nx;
            if (og + 1u == (tg + 1u) * nx) xb_add(&bar[XB_TOPGEN], 1u);
            else XB_SPIN(xb_ld(&bar[XB_TOPGEN]) == tg, bar);
            __builtin_amdgcn_fence(__ATOMIC_ACQUIRE, "agent");
            xb_add(&bar[XB_XGEN(b.x)], 1u);
            asm volatile("s_waitcnt vmcnt(0)" ::: "memory");
        } else {
            XB_SPIN(xb_ld(&bar[XB_XGEN(b.x)]) == gen, bar);
            __builtin_amdgcn_fence(__ATOMIC_ACQUIRE, "agent");
            asm volatile("s_waitcnt vmcnt(0)" ::: "memory");
        }
    }
    __syncthreads();
}

struct Args { const float* in[36]; float* out; unsigned char* ws; int ph_lo, ph_hi; };
enum { I_X = 0, I_P, I_WIN, I_BIN, I_LAMRE, I_LAMIM, I_LOGDT, I_BRE, I_BIM, I_CRE, I_CIM, I_SSMD, I_WGLU, I_BGLU, I_WDW, I_BDW, I_CLNG, I_CLNB, I_WO, I_BO, I_LN1G, I_LN1B,
       I_WRG, I_BRG, I_WRE, I_BRE2, I_WGATE, I_WUP, I_WDOWN, I_LN2G, I_LN2B, I_WP, I_WPG, I_BPG, I_LN3G, I_LN3B };
struct Frame {
    LAS unsigned char* lds;
    int tid, lane, wave, blk, G;
    int z;
    const float* const* in; float* out; unsigned char* ws;
};
__device__ __forceinline__ const float* inp(const Frame& F, int i) { return F.in[i + F.z]; }
__device__ __forceinline__ unsigned char* wsp(const Frame& F, size_t off) { return F.ws + (off + (size_t)(unsigned)F.z); }
__device__ __forceinline__ bf16* wsb(const Frame& F, size_t off) { return (bf16*)wsp(F, off); }
__device__ __forceinline__ bf16* wlayer(const Frame& F, int l, size_t off) { return (bf16*)wsp(F, WS_W0 + (size_t)l * W_LAYER + off); }
__device__ __forceinline__ unsigned* ctlw(const Frame& F) { return (unsigned*)wsp(F, WS_CTL); }

using pg8::Unit; using pg8::HALF; using pg8::BM;
__device__ __forceinline__ v4u ld16(const void* base, unsigned boff) { return *(const v4u*)((const char*)base + boff); }
__device__ __forceinline__ void st16(void* base, unsigned boff, v4u v) { *(v4u*)((char*)base + boff) = v; }
__device__ __forceinline__ f32x4 ldf4(const void* base, unsigned boff) { return *(const f32x4*)((const char*)base + boff); }
__device__ __forceinline__ void stf4(void* base, unsigned boff, f32x4 v) { *(f32x4*)((char*)base + boff) = v; }
#define EPI_PIN() asm volatile("" : "+v"(fr), "+v"(fq))
struct EpiIn {
    static constexpr bool PERM = true;
    bf16* U; bf16* HC; const float* bias;
    __device__ __forceinline__ void operator()(const f32x4 (&acc)[2][2][4][2], const Unit& u, int wr, int wc, int fr, int fq) const {
        EPI_PIN();
        const unsigned row0 = u.pm * BM + wr * 64 + fr, cl = wc * 32 + 8 * fq;
        if (u.pn < 4) {
            f32x4 bv[2][2];
#pragma unroll
            for (int bj = 0; bj < 2; ++bj)
#pragma unroll
                for (int n = 0; n < 2; ++n) bv[bj][n] = ldf4(bias, (u.pn * BM + bj * HALF + cl + 4 * n) * 4u);
#pragma unroll
            for (int ai = 0; ai < 2; ++ai)
#pragma unroll
                for (int m = 0; m < 4; ++m) { const unsigned off = ((row0 + ai * HALF + m * 16) * SSMW + u.pn * BM + cl) * 2u;
#pragma unroll
                    for (int bj = 0; bj < 2; ++bj) { const f32x4 v0 = acc[ai][bj][m][0] + bv[bj][0], v1 = acc[ai][bj][m][1] + bv[bj][1];
                        v4u w; w.x = pk2(v0[0], v0[1]); w.y = pk2(v0[2], v0[3]); w.z = pk2(v1[0], v1[1]); w.w = pk2(v1[2], v1[3]);
                        st16(U, off + bj * HALF * 2u, w); } }
        } else {
            const unsigned chn = (u.pn - 4) * HALF + cl;
            f32x4 bvv[2], bgg[2];
#pragma unroll
            for (int n = 0; n < 2; ++n) { bvv[n] = ldf4(bias, (SSMW + chn + 4 * n) * 4u); bgg[n] = ldf4(bias, (SSMW + CONVW + chn + 4 * n) * 4u); }
#pragma unroll
            for (int ai = 0; ai < 2; ++ai)
#pragma unroll
                for (int m = 0; m < 4; ++m) { const unsigned off = ((row0 + ai * HALF + m * 16) * CONVW + chn) * 2u;
                    float o[8];
#pragma unroll
                    for (int n = 0; n < 2; ++n) { const f32x4 vv = acc[ai][0][m][n] + bvv[n], gg = acc[ai][1][m][n] + bgg[n];
#pragma unroll
                        for (int j = 0; j < 4; ++j) o[4 * n + j] = vv[j] * sigm(gg[j]); }
                    st16(HC, off, pack8(o)); }
        }
    }
};
struct EpiGlu {
    static constexpr bool PERM = true;
    const bf16* Z; bf16* MIX; const float* bias;
    __device__ __forceinline__ void operator()(const f32x4 (&acc)[2][2][4][2], const Unit& u, int wr, int wc, int fr, int fq) const {
        EPI_PIN();
        const unsigned row0 = u.pm * BM + wr * 64 + fr, col0 = u.pc * BM + wc * 32 + 8 * fq;
        f32x4 bv[2][2];
#pragma unroll
        for (int bj = 0; bj < 2; ++bj)
#pragma unroll
            for (int n = 0; n < 2; ++n) bv[bj][n] = ldf4(bias, (col0 + bj * HALF + 4 * n) * 4u);
#pragma unroll
        for (int ai = 0; ai < 2; ++ai)
#pragma unroll
            for (int m = 0; m < 4; ++m) { const unsigned row = row0 + ai * HALF + m * 16;
#pragma unroll
                for (int bj = 0; bj < 2; ++bj) { const unsigned col = col0 + bj * HALF;
                    float zf[8]; unpack8(ld16(Z, (row * SSMW + col) * 2u), zf);
                    const f32x4 v0 = acc[ai][bj][m][0] + bv[bj][0], v1 = acc[ai][bj][m][1] + bv[bj][1];
                    float o[8];
#pragma unroll
                    for (int j = 0; j < 4; ++j) { o[j] = zf[j] * sigm(v0[j]); o[4 + j] = zf[4 + j] * sigm(v1[j]); }
                    st16(MIX, (row * D_MODEL + col) * 2u, pack8(o)); }
                asm volatile("" ::: "memory"); }
    }
};
struct EpiPlain {
    static constexpr bool PERM = true;
    bf16* O; int ldc;
    __device__ __forceinline__ void operator()(const f32x4 (&acc)[2][2][4][2], const Unit& u, int wr, int wc, int fr, int fq) const {
        EPI_PIN();
        const unsigned row0 = u.pm * BM + wr * 64 + fr, col0 = u.pc * BM + wc * 32 + 8 * fq;
#pragma unroll
        for (int ai = 0; ai < 2; ++ai)
#pragma unroll
            for (int m = 0; m < 4; ++m) { const unsigned off = ((row0 + ai * HALF + m * 16) * (unsigned)ldc + col0) * 2u;
#pragma unroll
                for (int bj = 0; bj < 2; ++bj) { const f32x4 v0 = acc[ai][bj][m][0], v1 = acc[ai][bj][m][1];
                    v4u w; w.x = pk2(v0[0], v0[1]); w.y = pk2(v0[2], v0[3]); w.z = pk2(v1[0], v1[1]); w.w = pk2(v1[2], v1[3]);
                    st16(O, off + bj * HALF * 2u, w); } }
    }
};
struct EpiOut {
    static constexpr bool PERM = true;
    const bf16* XB; float* V; const float* bias;
    __device__ __forceinline__ void operator()(const f32x4 (&acc)[2][2][4][2], const Unit& u, int wr, int wc, int fr, int fq) const {
        EPI_PIN();
        const unsigned row0 = u.pm * BM + wr * 64 + fr, col0 = u.pc * BM + wc * 32 + 8 * fq;
        f32x4 bv[2][2];
#pragma unroll
        for (int bj = 0; bj < 2; ++bj)
#pragma unroll
            for (int n = 0; n < 2; ++n) bv[bj][n] = ldf4(bias, (col0 + bj * HALF + 4 * n) * 4u);
#pragma unroll
        for (int ai = 0; ai < 2; ++ai)
#pragma unroll
            for (int m = 0; m < 4; ++m) { const unsigned eoff = (row0 + ai * HALF + m * 16) * D_MODEL + col0;
#pragma unroll
                for (int bj = 0; bj < 2; ++bj) { float xf[8]; unpack8(ld16(XB, (eoff + bj * HALF) * 2u), xf);
                    f32x4 o0 = acc[ai][bj][m][0] + bv[bj][0], o1 = acc[ai][bj][m][1] + bv[bj][1];
#pragma unroll
                    for (int j = 0; j < 4; ++j) { o0[j] += ALPHA * xf[j]; o1[j] += ALPHA * xf[4 + j]; }
                    stf4(V, (eoff + bj * HALF) * 4u, o0); stf4(V, (eoff + bj * HALF + 4) * 4u, o1); }
                asm volatile("" ::: "memory"); }
    }
};
struct EpiMoeUp {
    static constexpr bool PERM = true;
    bf16* HS; const float* roww;
    __device__ __forceinline__ void operator()(const f32x4 (&acc)[2][2][4][2], const Unit& u, int wr, int wc, int fr, int fq) const {
        EPI_PIN();
        const unsigned row0 = u.pm * BM + wr * 64 + fr, cl = u.pc * HALF + wc * 32 + 8 * fq;
#pragma unroll
        for (int ai = 0; ai < 2; ++ai)
#pragma unroll
            for (int m = 0; m < 4; ++m) { const unsigned row = row0 + ai * HALF + m * 16; const float rw = *(const float*)((const char*)roww + row * 4u);
                float o[8];
#pragma unroll
                for (int n = 0; n < 2; ++n) { const f32x4 gg = acc[ai][0][m][n], uu = acc[ai][1][m][n];
#pragma unroll
                    for (int j = 0; j < 4; ++j) o[4 * n + j] = silu_f(gg[j]) * uu[j] * rw; }
                st16(HS, (row * EH + cl) * 2u, pack8(o)); }
    }
};
struct EpiGate {
    static constexpr bool PERM = true;
    const bf16* H2; const bf16* E1; float* V; const float* bias;
    __device__ __forceinline__ void operator()(const f32x4 (&acc)[2][2][4][2], const Unit& u, int wr, int wc, int fr, int fq) const {
        EPI_PIN();
        const unsigned row0 = u.pm * BM + wr * 64 + fr, col0 = u.pc * BM + wc * 32 + 8 * fq;
        f32x4 bv[2][2];
#pragma unroll
        for (int bj = 0; bj < 2; ++bj)
#pragma unroll
            for (int n = 0; n < 2; ++n) bv[bj][n] = ldf4(bias, (col0 + bj * HALF + 4 * n) * 4u);
#pragma unroll
        for (int ai = 0; ai < 2; ++ai)
#pragma unroll
            for (int m = 0; m < 4; ++m) { const unsigned eoff = (row0 + ai * HALF + m * 16) * D_MODEL + col0;
#pragma unroll
                for (int bj = 0; bj < 2; ++bj) { float hf[8], ef[8]; unpack8(ld16(H2, (eoff + bj * HALF) * 2u), hf); unpack8(ld16(E1, (eoff + bj * HALF) * 2u), ef);
                    const f32x4 a0 = acc[ai][bj][m][0] + bv[bj][0], a1 = acc[ai][bj][m][1] + bv[bj][1]; f32x4 o0, o1;
#pragma unroll
                    for (int j = 0; j < 4; ++j) { o0[j] = ALPHA * hf[j] + ef[j] * sigm(a0[j]); o1[j] = ALPHA * hf[4 + j] + ef[4 + j] * sigm(a1[j]); }
                    stf4(V, (eoff + bj * HALF) * 4u, o0); stf4(V, (eoff + bj * HALF + 4) * 4u, o1); }
                asm volatile("" ::: "memory"); }
    }
};

__device__ __forceinline__ void transpose_tile(const float* src, int ldn, int k0, int n0, bf16* dst, size_t drow0, int ldk, LAS float* scr, int lane) {
    const int lr = lane >> 4, lc = (lane & 15) * 4;
#pragma unroll 4
    for (int i = 0; i < 16; ++i) { const int kk = 4 * i + lr; const f32x4 v = *(const f32x4*)(src + (size_t)(k0 + kk) * ldn + n0 + lc);
        LAS float* s = scr + kk * 65 + lc; s[0] = v[0]; s[1] = v[1]; s[2] = v[2]; s[3] = v[3]; }
    LDS_WAIT(); asm volatile("" ::: "memory");
    const int kc = lane & 7;
#pragma unroll 2
    for (int j = 0; j < 8; ++j) { const int n = (lane >> 3) + 8 * j; const LAS float* s = scr + (8 * kc) * 65 + n;
        v4u o; o.x = pk2(s[0], s[65]); o.y = pk2(s[2 * 65], s[3 * 65]); o.z = pk2(s[4 * 65], s[5 * 65]); o.w = pk2(s[6 * 65], s[7 * 65]);
        *(v4u*)(dst + (drow0 + n) * (size_t)ldk + k0 + 8 * kc) = o; }
    LDS_WAIT(); asm volatile("" ::: "memory");
}
__device__ __forceinline__ void p_prologue(Frame& F) {
    LAS float* scr = (LAS float*)(F.lds + F.wave * 16640);
    const int gw = F.blk * NWAVES + F.wave, NGW = F.G * NWAVES;
    constexpr int T_IN = 32 * 48, T_GLU = 16 * 16, T_O = 32 * 32, T_G = 32 * 128, T_D = 32 * 128, T_PG = 32 * 32, T_P = 4 * 32;
    constexpr int T_LAYER = T_IN + T_GLU + T_O + 2 * T_G + T_D + T_PG + T_P;
    for (int it = gw; it < T_LAYER * DEPTH; it += NGW) {
        const int l = it / T_LAYER; int r = it % T_LAYER;
        if (r < T_IN) { const int kt = r / 48, ntl = r % 48, n0 = 64 * ntl; int dr;
            if (n0 < SSMW) dr = n0; else { const int q = n0 - SSMW, part = q / CONVW, cc = q % CONVW; dr = SSMW + (cc / 128) * 256 + part * 128 + (cc % 128); }
            transpose_tile(inp(F, I_WIN) + (size_t)l * D_MODEL * INW, INW, 64 * kt, n0, wlayer(F, l, WO_IN), dr, D_MODEL, scr, F.lane); continue; } r -= T_IN;
        if (r < T_GLU) { const int kt = r / 16, ntl = r % 16;
            transpose_tile(inp(F, I_WGLU) + (size_t)l * SSMW * SSMW, SSMW, 64 * kt, 64 * ntl, wlayer(F, l, WO_GLU), 64 * ntl, SSMW, scr, F.lane); continue; } r -= T_GLU;
        if (r < T_O) { const int kt = r / 32, ntl = r % 32;
            transpose_tile(inp(F, I_WO) + (size_t)l * D_MODEL * D_MODEL, D_MODEL, 64 * kt, 64 * ntl, wlayer(F, l, WO_O), 64 * ntl, D_MODEL, scr, F.lane); continue; } r -= T_O;
        if (r < 2 * T_G) { const int up = r / T_G; const int rr = r % T_G; const int e = rr / 128, q = rr % 128, kt = q / 4, ntl = q % 4, n0 = 64 * ntl;
            const float* src = inp(F, up ? I_WUP : I_WGATE) + ((size_t)(l * NEXP + e) * D_MODEL) * EH;
            transpose_tile(src, EH, 64 * kt, n0, wlayer(F, l, WO_GU), (size_t)e * 512 + (n0 / 128) * 256 + up * 128 + (n0 % 128), D_MODEL, scr, F.lane); continue; } r -= 2 * T_G;
        if (r < T_D) { const int e = r / 128, q = r % 128, kt = q / 32, ntl = q % 32;
            const float* src = inp(F, I_WDOWN) + ((size_t)(l * NEXP + e) * EH) * D_MODEL;
            transpose_tile(src, D_MODEL, 64 * kt, 64 * ntl, wlayer(F, l, WO_D), (size_t)e * D_MODEL + 64 * ntl, EH, scr, F.lane); continue; } r -= T_D;
        if (r < T_PG) { const int kt = r / 32, ntl = r % 32;
            transpose_tile(inp(F, I_WPG) + (size_t)l * D_MODEL * D_MODEL, D_MODEL, 64 * kt, 64 * ntl, wlayer(F, l, WO_PG), 64 * ntl, D_MODEL, scr, F.lane); continue; } r -= T_PG;
        { const int kt = r / 32, ntl = r % 32;
            transpose_tile(inp(F, I_WP) + (size_t)l * PLE * D_MODEL, D_MODEL, 64 * kt, 64 * ntl, wlayer(F, l, WO_P), 64 * ntl, PLE, scr, F.lane); }
    }
    const int gt = F.blk * (NWAVES * 64) + F.tid, NGT = F.G * NWAVES * 64;
    for (int i = gt; i < DEPTH * 48 * D_MODEL; i += NGT) { const int l = i / (48 * D_MODEL), q = i % (48 * D_MODEL), n = q / D_MODEL, k = q % D_MODEL;
        float v = 0.f; if (n < NEG) v = inp(F, I_WRG)[((size_t)l * D_MODEL + k) * NEG + n]; else if (n < NEG + NEXP) v = inp(F, I_WRE)[((size_t)l * D_MODEL + k) * NEXP + (n - NEG)];
        wlayer(F, l, WO_R)[(size_t)n * D_MODEL + k] = (bf16)f2bf(v); }
    { const f32x4* xs = (const f32x4*)inp(F, I_X); v4u* xd = (v4u*)wsb(F, WS_XB);
      for (int i = gt; i < NTOK * D_MODEL / 8; i += NGT) { const f32x4 a = xs[2 * i], b = xs[2 * i + 1]; v4u w; w.x = pk2(a[0], a[1]); w.y = pk2(a[2], a[3]); w.z = pk2(b[0], b[1]); w.w = pk2(b[2], b[3]); xd[i] = w; }
      const f32x4* ps = (const f32x4*)inp(F, I_P); v4u* pd = (v4u*)wsb(F, WS_PB);
      for (int i = gt; i < DEPTH * NTOK * PLE / 8; i += NGT) { const f32x4 a = ps[2 * i], b = ps[2 * i + 1]; v4u w; w.x = pk2(a[0], a[1]); w.y = pk2(a[2], a[3]); w.z = pk2(b[0], b[1]); w.w = pk2(b[2], b[3]); pd[i] = w; } }
}

constexpr int BU_PITCH = 132;
constexpr int SB_PITCH = 272;
__device__ __forceinline__ void scan_item(Frame& F, int l, int item) {
    const int b = item >> 6, g = item & 63, lane = F.lane, w = F.wave;
    LAS float* BUf = (LAS float*)(F.lds + w * 12800);
    LAS unsigned char* Sb = F.lds + w * 12800 + 8448;
    LAS f32x2* coefT = (LAS f32x2*)(F.lds + 102400);
    LAS f32x2* Ebuf = (LAS f32x2*)(F.lds + 102400 + 512);
    const int lg = l * NGRP + g;
    const float dt = expf(inp(F, I_LOGDT)[lg]);
    const float lre = fminf(inp(F, I_LAMRE)[lg * NST + lane], -1e-4f), lim = inp(F, I_LAMIM)[lg * NST + lane];
    const float mag = expf(lre * dt); float sn, cs; sincosf(lim * dt, &sn, &cs);
    const float lbr = mag * cs, lbi = mag * sn;
    { const float nr = lbr - 1.f, ni = lbi, den = lre * lre + lim * lim; coefT[lane] = (f32x2){(nr * lre + ni * lim) / den, (ni * lre - nr * lim) / den}; }
    float l2r = lbr, l2i = lbi;
#pragma unroll
    for (int i = 0; i < 8; ++i) { const float tr = l2r * l2r - l2i * l2i, ti = 2.f * l2r * l2i; l2r = tr; l2i = ti; }
    LDS_WAIT(); __builtin_amdgcn_wave_barrier(); asm volatile("" ::: "memory");
    __syncthreads();
    const int fr = lane & 15, kq = lane >> 4;
    bf16x8 Xf[8];
#pragma unroll
    for (int jt = 0; jt < 8; ++jt) { const int pc = (16 * jt + fr) & 63; const f32x2 cf = coefT[pc]; v4u wv = (v4u){0u, 0u, 0u, 0u};
        if (kq < 2) { const float* bre = inp(F, I_BRE) + ((size_t)lg * NST + pc) * CH + 8 * kq; const float* bim = inp(F, I_BIM) + ((size_t)lg * NST + pc) * CH + 8 * kq; float o[8];
#pragma unroll
            for (int j = 0; j < 8; ++j) { const float br = bre[j], bi = bim[j]; o[j] = (jt < 4) ? (cf.x * br - cf.y * bi) : (cf.x * bi + cf.y * br); }
            wv = pack8(o); }
        Xf[jt] = __builtin_bit_cast(bf16x8, wv); }
    bf16x8 Cf[4];
#pragma unroll
    for (int kk = 0; kk < 4; ++kk) { const float* cre = inp(F, I_CRE) + ((size_t)lg * CH + fr) * NST + 16 * kk + 4 * kq; const float* cim = inp(F, I_CIM) + ((size_t)lg * CH + fr) * NST + 16 * kk + 4 * kq; float o[8];
#pragma unroll
        for (int j = 0; j < 4; ++j) { o[2 * j] = cre[j]; o[2 * j + 1] = -cim[j]; }
        Cf[kk] = __builtin_bit_cast(bf16x8, pack8(o)); }
    f32x4 dsk = *(const f32x4*)(inp(F, I_SSMD) + (size_t)l * SSMW + g * CH + 4 * kq);
    const bf16* Ub = wsb(F, WS_U); bf16* Zb = wsb(F, WS_Z);
    const size_t tok0 = (size_t)b * SEQ + 256 * w;
    float sr = 0.f, si = 0.f;
    for (int pass = 0; pass < 2; ++pass) {
        for (int sc = 0; sc < 16; ++sc) {
            const size_t tok = tok0 + 16 * sc + fr;
            v4u uw = (v4u){0u, 0u, 0u, 0u};
            if (kq < 2) uw = *(const v4u*)(Ub + tok * SSMW + g * CH + 8 * kq);
            const bf16x8 Uf = __builtin_bit_cast(bf16x8, uw);
#pragma unroll
            for (int jt = 0; jt < 8; ++jt) { f32x4 a = (f32x4){0.f, 0.f, 0.f, 0.f}; a = __builtin_amdgcn_mfma_f32_16x16x32_bf16(Xf[jt], Uf, a, 0, 0, 0);
                *(LAS f32x4*)(BUf + fr * BU_PITCH + 16 * jt + 4 * kq) = a; }
            LDS_WAIT(); __builtin_amdgcn_wave_barrier(); asm volatile("" ::: "memory");
#pragma unroll
            for (int t = 0; t < 16; ++t) { const float br = BUf[t * BU_PITCH + lane], bi = BUf[t * BU_PITCH + 64 + lane];
                const float nr = lbr * sr - lbi * si + br, ni = lbr * si + lbi * sr + bi; sr = nr; si = ni;
                if (pass == 1) *(LAS unsigned*)(Sb + t * SB_PITCH + 4 * lane) = pk2(sr, si); }
            LDS_WAIT(); __builtin_amdgcn_wave_barrier(); asm volatile("" ::: "memory");
            if (pass == 1) {
                f32x4 y = (f32x4){0.f, 0.f, 0.f, 0.f};
#pragma unroll
                for (int kk = 0; kk < 4; ++kk) { const bf16x8 Sf = *(const LAS bf16x8*)(Sb + fr * SB_PITCH + (32 * kk + 8 * kq) * 2); y = __builtin_amdgcn_mfma_f32_16x16x32_bf16(Cf[kk], Sf, y, 0, 0, 0); }
                const v2u u4 = *(const v2u*)(Ub + tok * SSMW + g * CH + 4 * kq);
                const float y0 = y[0] + dsk[0] * bflo(u4.x), y1 = y[1] + dsk[1] * bfhi(u4.x), y2 = y[2] + dsk[2] * bflo(u4.y), y3 = y[3] + dsk[3] * bfhi(u4.y);
                v2u o; o.x = pk2(gelu_tanh(y0), gelu_tanh(y1)); o.y = pk2(gelu_tanh(y2), gelu_tanh(y3));
                *(v2u*)(Zb + tok * SSMW + g * CH + 4 * kq) = o;
                LDS_WAIT(); __builtin_amdgcn_wave_barrier(); asm volatile("" ::: "memory");
            }
        }
        if (pass == 0) {
            Ebuf[w * 64 + lane] = (f32x2){sr, si};
            LDS_WAIT(); __syncthreads();
            float cr = 0.f, ci = 0.f;
            for (int j = 0; j < w; ++j) { const f32x2 e = Ebuf[j * 64 + lane]; const float nr = l2r * cr - l2i * ci + e.x, ni = l2r * ci + l2i * cr + e.y; cr = nr; ci = ni; }
            sr = cr; si = ci;
        }
    }
    __syncthreads();
}

__device__ __forceinline__ void conv_item(Frame& F, int l, int item) {
    const int tid = F.tid, c2 = 2 * tid;
    const int tok0 = item * 16, ts0 = tok0 & (SEQ - 1);
    const bf16* HC = wsb(F, WS_HC); bf16* MIX = wsb(F, WS_MIX);
    LAS float* P = (LAS float*)F.lds;
    LAS float* ST = (LAS float*)(F.lds + 65536);
    unsigned win[46];
#pragma unroll
    for (int r = 0; r < 46; ++r) { const int tt = ts0 - 30 + r; win[r] = (tt >= 0) ? *(const unsigned*)(HC + (size_t)(tok0 - 30 + r) * CONVW + c2) : 0u; }
    float a0[16], a1[16];
    { const f32x2 bb = *(const f32x2*)(inp(F, I_BDW) + (size_t)l * CONVW + c2);
#pragma unroll
      for (int i = 0; i < 16; ++i) { a0[i] = bb.x; a1[i] = bb.y; } }
    const float* wdw = inp(F, I_WDW) + (size_t)l * CONV_K * CONVW + c2;
#pragma unroll
    for (int j = 0; j < CONV_K; ++j) { const f32x2 wj = *(const f32x2*)(wdw + (size_t)j * CONVW);
#pragma unroll
        for (int i = 0; i < 16; ++i) { a0[i] += wj.x * bflo(win[i + j]); a1[i] += wj.y * bfhi(win[i + j]); } }
#pragma unroll
    for (int i = 0; i < 16; ++i) { P[(2 * i) * 512 + tid] = a0[i] + a1[i]; P[(2 * i + 1) * 512 + tid] = a0[i] * a0[i] + a1[i] * a1[i]; }
    LDS_WAIT(); __syncthreads();
    { const int v = tid >> 4, sub = tid & 15; float s = 0.f;
#pragma unroll 8
      for (int q = 0; q < 32; ++q) s += P[v * 512 + sub + 16 * q];
      s += swz_xor<8>(s); s += swz_xor<4>(s); s += swz_xor<2>(s); s += swz_xor<1>(s);
      if (sub == 0) ST[v] = s; }
    LDS_WAIT(); __syncthreads();
    const f32x2 gg = *(const f32x2*)(inp(F, I_CLNG) + (size_t)l * CONVW + c2), bb = *(const f32x2*)(inp(F, I_CLNB) + (size_t)l * CONVW + c2);
#pragma unroll
    for (int i = 0; i < 16; ++i) { const float mean = ST[2 * i] * (1.f / CONVW); const float var = ST[2 * i + 1] * (1.f / CONVW) - mean * mean; const float rstd = rsqrtf(fmaxf(var, 0.f) + LN_EPS);
        const float o0 = silu_f((a0[i] - mean) * rstd * gg.x + bb.x), o1 = silu_f((a1[i] - mean) * rstd * gg.y + bb.y);
        *(unsigned*)(MIX + (size_t)(tok0 + i) * D_MODEL + SSMW + c2) = pk2(o0, o1); }
    __syncthreads();
}

__device__ __forceinline__ void ln_row(float (&x)[4][8], const float* g, const float* b, int lane) {
    float s = 0.f;
#pragma unroll
    for (int j = 0; j < 4; ++j)
#pragma unroll
        for (int i = 0; i < 8; ++i) s += x[j][i];
    const float mean = wave_sum(s) * (1.f / D_MODEL); float q = 0.f;
#pragma unroll
    for (int j = 0; j < 4; ++j)
#pragma unroll
        for (int i = 0; i < 8; ++i) { x[j][i] -= mean; q += x[j][i] * x[j][i]; }
    const float rstd = rsqrtf(wave_sum(q) * (1.f / D_MODEL) + LN_EPS);
#pragma unroll
    for (int j = 0; j < 4; ++j) { const f32x4 g0 = *(const f32x4*)(g + 8 * lane + 512 * j), g1 = *(const f32x4*)(g + 8 * lane + 512 * j + 4), b0 = *(const f32x4*)(b + 8 * lane + 512 * j), b1 = *(const f32x4*)(b + 8 * lane + 512 * j + 4);
#pragma unroll
        for (int i = 0; i < 4; ++i) { x[j][i] = x[j][i] * rstd * g0[i] + b0[i]; x[j][4 + i] = x[j][4 + i] * rstd * g1[i] + b1[i]; } }
}
__device__ __forceinline__ void load_row_f32(const float* p, float (&x)[4][8], int lane) {
#pragma unroll
    for (int j = 0; j < 4; ++j) { const f32x4 a = *(const f32x4*)(p + 8 * lane + 512 * j), b = *(const f32x4*)(p + 8 * lane + 512 * j + 4);
#pragma unroll
        for (int i = 0; i < 4; ++i) { x[j][i] = a[i]; x[j][4 + i] = b[i]; } }
}

constexpr int HR_PITCH = 4112;
__device__ __forceinline__ void ln1_router_item(Frame& F, int l, int item) {
    const int lane = F.lane, w = F.wave, tid = F.tid;
    LAS unsigned char* Hrow = F.lds;
    LAS float* Part = (LAS float*)(F.lds + 65792);
    LAS float* Lg = (LAS float*)(F.lds + 65792 + 24576);
    bf16* H1 = wsb(F, WS_H1);
    const float* V = (const float*)(wsp(F, WS_V));
#pragma unroll 1
    for (int rr = 0; rr < 2; ++rr) { const int lr = 2 * w + rr; const size_t row = (size_t)item * 16 + lr;
        float x[4][8]; load_row_f32(V + row * D_MODEL, x, lane);
        ln_row(x, inp(F, I_LN1G) + (size_t)l * D_MODEL, inp(F, I_LN1B) + (size_t)l * D_MODEL, lane);
#pragma unroll
        for (int j = 0; j < 4; ++j) { const v4u pw = pack8(x[j]); *(v4u*)(H1 + row * D_MODEL + 8 * lane + 512 * j) = pw; *(LAS v4u*)(Hrow + lr * HR_PITCH + (8 * lane + 512 * j) * 2) = pw; } }
    LDS_WAIT(); __syncthreads();
    { const int fr = lane & 15, kq = lane >> 4; const bf16* Wr = wlayer(F, l, WO_R);
      f32x4 acc[3]; acc[0] = acc[1] = acc[2] = (f32x4){0.f, 0.f, 0.f, 0.f};
#pragma unroll 2
      for (int ks = 0; ks < 8; ++ks) { const int kb = 256 * w + 32 * ks + 8 * kq;
          const bf16x8 Af = *(const LAS bf16x8*)(Hrow + fr * HR_PITCH + kb * 2);
#pragma unroll
          for (int nt = 0; nt < 3; ++nt) { const bf16x8 Bf = __builtin_bit_cast(bf16x8, *(const v4u*)(Wr + (size_t)(16 * nt + fr) * D_MODEL + kb)); acc[nt] = __builtin_amdgcn_mfma_f32_16x16x32_bf16(Af, Bf, acc[nt], 0, 0, 0); } }
#pragma unroll
      for (int nt = 0; nt < 3; ++nt)
#pragma unroll
          for (int r = 0; r < 4; ++r) Part[(w * 16 + 4 * kq + r) * 48 + 16 * nt + fr] = acc[nt][r]; }
    LDS_WAIT(); __syncthreads();
    for (int o = tid; o < 16 * 48; o += NWAVES * 64) { float s = 0.f;
#pragma unroll
        for (int ww = 0; ww < 8; ++ww) s += Part[ww * 768 + o];
        const int n = o % 48; if (n < NEG) s += inp(F, I_BRG)[l * NEG + n]; else if (n < NEG + NEXP) s += inp(F, I_BRE2)[l * NEXP + n - NEG];
        Lg[o] = s; }
    LDS_WAIT(); __syncthreads();
    if (tid < 16) { const LAS float* lg = Lg + tid * 48; const int tokn = item * 16 + tid;
        int gi = 0; float gm = lg[0];
#pragma unroll
        for (int i = 1; i < NEG; ++i) if (lg[i] > gm) { gm = lg[i]; gi = i; }
        float gs = 0.f;
#pragma unroll
        for (int i = 0; i < NEG; ++i) gs += __expf(lg[i] - gm);
        const float gp = 1.f / gs;
        const LAS float* el = lg + NEG + EPG * gi;
        int i0 = 0; float v0 = el[0];
#pragma unroll
        for (int i = 1; i < EPG; ++i) if (el[i] > v0) { v0 = el[i]; i0 = i; }
        int i1 = -1; float v1 = -3.0e38f;
#pragma unroll
        for (int i = 0; i < EPG; ++i) if (i != i0 && el[i] > v1) { v1 = el[i]; i1 = i; }
        const float ex = __expf(v1 - v0), w0 = gp / (1.f + ex), w1 = gp * ex / (1.f + ex);
        const int e0 = gi * EPG + i0, e1 = gi * EPG + i1;
        unsigned* cnt = ctlw(F) + CW_CNT + l * NEXP * 16;
        const unsigned p0 = atomicAdd(cnt + e0 * 16, 1u), p1 = atomicAdd(cnt + e1 * 16, 1u);
        int* tk = (int*)(wsp(F, WS_TOK)); float* tw = (float*)(wsp(F, WS_TOK + 256 * 1024));
        tk[tokn * 4 + 0] = e0; tk[tokn * 4 + 1] = e1; tk[tokn * 4 + 2] = (int)p0; tk[tokn * 4 + 3] = (int)p1; tw[tokn * 2 + 0] = w0; tw[tokn * 2 + 1] = w1; }
    __syncthreads();
}

__device__ __forceinline__ void p_gather(Frame& F, int l) {
    LAS int* off = (LAS int*)F.lds;
    const unsigned* cnt = ctlw(F) + CW_CNT + l * NEXP * 16;
    if (F.tid == 0) { int tb = 0; int* te = (int*)(ctlw(F) + CW_TE + l * 128);
#pragma unroll 1
        for (int e = 0; e < NEXP; ++e) { const int c = (int)cnt[e * 16], nt = (c + 255) >> 8; off[e] = tb * 256;
            if (F.blk == 0) {
#pragma unroll 1
                for (int t = 0; t < nt; ++t) te[tb + t] = e; }
            tb += nt; }
        if (F.blk == 0) *(int*)(ctlw(F) + CW_NT + 64 * l) = tb; }
    LDS_WAIT(); __syncthreads();
    const int* tk = (const int*)(wsp(F, WS_TOK)); const float* tw = (const float*)(wsp(F, WS_TOK + 256 * 1024));
    int* tslot = (int*)(wsp(F, WS_TOK + 512 * 1024)); float* roww = (float*)(wsp(F, WS_ROWW));
    const bf16* H1 = wsb(F, WS_H1); bf16* XS = wsb(F, WS_XS);
    for (int pr = F.blk * NWAVES + F.wave; pr < NTOK * 2; pr += F.G * NWAVES) { const int t = pr >> 1, k = pr & 1;
        const int e = tk[t * 4 + k], pos = tk[t * 4 + 2 + k]; const int slot = off[e] + pos;
        const v4u* s = (const v4u*)(H1 + (size_t)t * D_MODEL); v4u* d = (v4u*)(XS + (size_t)slot * D_MODEL);
#pragma unroll
        for (int j = 0; j < 4; ++j) d[F.lane + 64 * j] = s[F.lane + 64 * j];
        if (F.lane == 0) { roww[slot] = tw[t * 2 + k]; tslot[pr] = slot; } }
    __syncthreads();
}

__device__ __forceinline__ void p_ln2(Frame& F, int l) {
    const bf16* H1 = wsb(F, WS_H1); const bf16* OS = wsb(F, WS_XS); bf16* H2 = wsb(F, WS_H2);
    const int* tslot = (const int*)(wsp(F, WS_TOK + 512 * 1024));
    for (int row = F.blk * NWAVES + F.wave; row < NTOK; row += F.G * NWAVES) { const int s0 = tslot[2 * row], s1 = tslot[2 * row + 1];
        float x[4][8];
#pragma unroll
        for (int j = 0; j < 4; ++j) { float a[8], b[8], c[8]; unpack8(*(const v4u*)(H1 + (size_t)row * D_MODEL + 8 * F.lane + 512 * j), a);
            unpack8(*(const v4u*)(OS + (size_t)s0 * D_MODEL + 8 * F.lane + 512 * j), b); unpack8(*(const v4u*)(OS + (size_t)s1 * D_MODEL + 8 * F.lane + 512 * j), c);
#pragma unroll
            for (int i = 0; i < 8; ++i) x[j][i] = ALPHA * a[i] + (b[i] + c[i]); }
        ln_row(x, inp(F, I_LN2G) + (size_t)l * D_MODEL, inp(F, I_LN2B) + (size_t)l * D_MODEL, F.lane);
#pragma unroll
        for (int j = 0; j < 4; ++j) *(v4u*)(H2 + (size_t)row * D_MODEL + 8 * F.lane + 512 * j) = pack8(x[j]); }
}
__device__ __forceinline__ void p_ln3(Frame& F, int l) {
    const float* V = (const float*)(wsp(F, WS_V)); bf16* XB = wsb(F, WS_XB);
    for (int row = F.blk * NWAVES + F.wave; row < NTOK; row += F.G * NWAVES) {
        float x[4][8]; load_row_f32(V + (size_t)row * D_MODEL, x, F.lane);
        ln_row(x, inp(F, I_LN3G) + (size_t)l * D_MODEL, inp(F, I_LN3B) + (size_t)l * D_MODEL, F.lane);
        if (l == DEPTH - 1) {
#pragma unroll
            for (int j = 0; j < 4; ++j) { *(f32x4*)(F.out + (size_t)row * D_MODEL + 8 * F.lane + 512 * j) = (f32x4){x[j][0], x[j][1], x[j][2], x[j][3]}; *(f32x4*)(F.out + (size_t)row * D_MODEL + 8 * F.lane + 512 * j + 4) = (f32x4){x[j][4], x[j][5], x[j][6], x[j][7]}; }
        } else {
#pragma unroll
            for (int j = 0; j < 4; ++j) *(v4u*)(XB + (size_t)row * D_MODEL + 8 * F.lane + 512 * j) = pack8(x[j]);
        }
    }
}

__global__ void __launch_bounds__(NWAVES * 64, 2) mk_fwd(Args args) {
    extern __shared__ __attribute__((aligned(16))) unsigned char lds[];
    Frame F;
    F.lds = (LAS unsigned char*)lds;
    F.tid = threadIdx.x; F.lane = F.tid & 63; F.wave = __builtin_amdgcn_readfirstlane(F.tid >> 6);
    const int wave0 = F.wave;
    F.blk = blockIdx.x; F.G = gridDim.x; F.z = 0; F.in = args.in; F.out = args.out; F.ws = args.ws;
    volatile LAS unsigned* MISC = (volatile LAS unsigned*)(F.lds + MISC_OFF);
    if (F.tid < 64) MISC[F.tid] = 0u;
    __syncthreads();
    const int lo = args.ph_lo, hi = args.ph_hi;
    XcdBarrier bar; bar.bar = (unsigned*)(args.ws + WS_CTL) + CW_BAR; bar.x = 0; bar.st = nullptr;
    if (hi - lo > 1) bar = xcd_barrier_post((unsigned*)(args.ws + WS_CTL) + CW_BAR, MISC + 8);
#define IN(k) (lo <= (k) && (k) < hi)
#define FRESH() do { int z_ = 0, g_ = gridDim.x, b_ = blockIdx.x, w_ = wave0; asm volatile("" : "+s"(z_), "+s"(g_), "+s"(b_), "+s"(w_)); \
    int l_ = (int)__builtin_amdgcn_mbcnt_hi(~0u, __builtin_amdgcn_mbcnt_lo(~0u, (unsigned)z_));   \
    F.z = z_; F.G = g_; F.blk = b_; F.wave = w_; F.lane = l_; F.tid = w_ * 64 + l_; } while (0)
#define SEAM(k) do { if (IN(k) && IN((k) + 1)) { int z_ = 0; asm volatile("" : "+s"(z_)); XcdBarrier bb_ = bar; bb_.bar = bar.bar + z_; bb_.x = bar.x + (unsigned)z_; xcd_barrier(bb_); } } while (0)
    LAS unsigned char* ring = F.lds;

    if (IN(0)) { FRESH(); p_prologue(F); SEAM(0); }

#pragma unroll 1
    for (int l = 0; l < DEPTH; ++l) {
        const int pb = 1 + PH_PER_LAYER * l;
        if (IN(pb + 0)) { FRESH();
            pg8::Gemm g{wsb(F, WS_XB), wlayer(F, l, WO_IN), NTOK, INW, D_MODEL}; pg8::StaticOrder S; S.init(NTOK, INW, F.G, F.blk);
            EpiIn E{wsb(F, WS_U), wsb(F, WS_HC), inp(F, I_BIN) + (size_t)l * INW};
            pg8::gemm_phase<EpiIn, pg8::StaticOrder, true, true>(ring, g, S, E, F.tid);
            SEAM(pb + 0);
        }
        if (IN(pb + 1)) { FRESH();
            for (int it = F.blk; it < BATCH * NGRP; it += F.G) scan_item(F, l, it);
            for (int it = F.blk; it < NTOK / 16; it += F.G) conv_item(F, l, it);
            SEAM(pb + 1);
        }
        if (IN(pb + 2)) { FRESH();
            { pg8::Gemm g{wsb(F, WS_Z), wlayer(F, l, WO_GLU), NTOK, SSMW, SSMW}; pg8::StaticOrder S; S.init(NTOK, SSMW, F.G, F.blk);
              EpiGlu E{wsb(F, WS_Z), wsb(F, WS_MIX), inp(F, I_BGLU) + (size_t)l * SSMW};
              pg8::gemm_phase<EpiGlu, pg8::StaticOrder, true, true>(ring, g, S, E, F.tid); }
            { pg8::Gemm g{wsb(F, WS_PB) + (size_t)l * NTOK * PLE, wlayer(F, l, WO_P), NTOK, D_MODEL, PLE}; pg8::StaticOrder S; S.init(NTOK, D_MODEL, F.G, (F.blk + 128) % F.G);
              EpiPlain E{wsb(F, WS_E1), D_MODEL};
              pg8::gemm_phase<EpiPlain, pg8::StaticOrder, true, true>(ring, g, S, E, F.tid); }
            SEAM(pb + 2);
        }
        if (IN(pb + 3)) { FRESH();
            pg8::Gemm g{wsb(F, WS_MIX), wlayer(F, l, WO_O), NTOK, D_MODEL, D_MODEL}; pg8::StaticOrder S; S.init(NTOK, D_MODEL, F.G, F.blk);
            EpiOut E{wsb(F, WS_XB), (float*)(wsp(F, WS_V)), inp(F, I_BO) + (size_t)l * D_MODEL};
            pg8::gemm_phase<EpiOut, pg8::StaticOrder, true, true>(ring, g, S, E, F.tid);
            SEAM(pb + 3);
        }
        if (IN(pb + 4)) { FRESH();
            for (int it = F.blk; it < NTOK / 16; it += F.G) ln1_router_item(F, l, it);
            SEAM(pb + 4);
        }
        if (IN(pb + 5)) { FRESH(); p_gather(F, l); SEAM(pb + 5); }
        if (IN(pb + 6)) { FRESH();
            const int ntl = *(const int*)(ctlw(F) + CW_NT + 64 * l);
            pg8::Gemm g{wsb(F, WS_XS), wlayer(F, l, WO_GU), SROWS, NEXP * 512, D_MODEL};
            pg8::MoeOrder S{(const int*)(ctlw(F) + CW_TE + l * 128), ntl, 2, F.G, F.blk};
            EpiMoeUp E{wsb(F, WS_HS), (const float*)(wsp(F, WS_ROWW))};
            pg8::gemm_phase<EpiMoeUp, pg8::MoeOrder, true, true>(ring, g, S, E, F.tid);
            SEAM(pb + 6);
        }
        if (IN(pb + 7)) { FRESH();
            const int ntl = *(const int*)(ctlw(F) + CW_NT + 64 * l);
            pg8::Gemm g{wsb(F, WS_HS), wlayer(F, l, WO_D), SROWS, NEXP * D_MODEL, EH};
            pg8::MoeOrder S{(const int*)(ctlw(F) + CW_TE + l * 128), ntl, 8, F.G, F.blk};
            EpiPlain E{wsb(F, WS_XS), D_MODEL};
            pg8::gemm_phase<EpiPlain, pg8::MoeOrder, true, true>(ring, g, S, E, F.tid);
            SEAM(pb + 7);
        }
        if (IN(pb + 8)) { FRESH(); p_ln2(F, l); SEAM(pb + 8); }
        if (IN(pb + 9)) { FRESH();
            pg8::Gemm g{wsb(F, WS_H2), wlayer(F, l, WO_PG), NTOK, D_MODEL, D_MODEL}; pg8::StaticOrder S; S.init(NTOK, D_MODEL, F.G, F.blk);
            EpiGate E{wsb(F, WS_H2), wsb(F, WS_E1), (float*)(wsp(F, WS_V)), inp(F, I_BPG) + (size_t)l * D_MODEL};
            pg8::gemm_phase<EpiGate, pg8::StaticOrder, true, true>(ring, g, S, E, F.tid);
            SEAM(pb + 9);
        }
        if (IN(pb + 10)) { FRESH(); p_ln3(F, l); SEAM(pb + 10); }
    }
#undef IN
#undef SEAM
}

extern "C" void kernel_launch(void* const* d_in, const int* in_sizes, int n_in, void* d_out, int out_size, void* d_ws, size_t ws_size, hipStream_t stream) {
    static int grid = 0;
    if (grid == 0) {
        if (n_in != 36 || in_sizes[0] != NTOK * D_MODEL || out_size != NTOK * D_MODEL || ws_size < WS_END) { fprintf(stderr, "kernel_launch: unexpected shapes (n_in %d, in0 %d, out %d, ws %zu < %zu)\n", n_in, n_in > 0 ? in_sizes[0] : -1, out_size, ws_size, (size_t)WS_END); grid = -1; return; }
        int dev = 0, cus = 0, per_cu = 0;
        if (hipGetDevice(&dev) != hipSuccess || hipDeviceGetAttribute(&cus, hipDeviceAttributeMultiprocessorCount, dev) != hipSuccess) { grid = -1; return; }
        if (hipFuncSetAttribute((const void*)mk_fwd, hipFuncAttributeMaxDynamicSharedMemorySize, LDS_BYTES) != hipSuccess) { fprintf(stderr, "kernel_launch: hipFuncSetAttribute failed\n"); grid = -1; return; }
        if (hipOccupancyMaxActiveBlocksPerMultiprocessor(&per_cu, (const void*)mk_fwd, NWAVES * 64, LDS_BYTES) != hipSuccess || per_cu < 1) fprintf(stderr, "kernel_launch: occupancy query reports %d\n", per_cu);
        (void)hipGetLastError();
        grid = cus;
    }
    if (grid < 0) return;
    if (hipMemsetAsync((char*)d_ws + WS_CTL, 0, CTL_ZERO_BYTES, stream) != hipSuccess) return;
    Args a{};
    for (int i = 0; i < 36; ++i) a.in[i] = (const float*)d_in[i];
    a.out = (float*)d_out; a.ws = (unsigned char*)d_ws;
#if MK_SINGLE
    a.ph_lo = 0; a.ph_hi = NPHASES;
    hipLaunchKernelGGL(mk_fwd, dim3(grid), dim3(NWAVES * 64), LDS_BYTES, stream, a);
#else
    for (int ph = 0; ph < NPHASES; ++ph) { a.ph_lo = ph; a.ph_hi = ph + 1;
        hipLaunchKernelGGL(mk_fwd, dim3(grid), dim3(NWAVES * 64), LDS_BYTES, stream, a); }
#endif
}
```

```cpp
#include <hip/hip_runtime.h>
#include <cstdio>
#include <cstdint>

#ifndef MK_SINGLE
#define MK_SINGLE 1
#endif
#ifndef PROBE_DUP
#define PROBE_DUP -1
#endif

namespace pg8 {
#define PG8_LAS __attribute__((address_space(3)))
typedef unsigned short bf16_t;
typedef short bf16x8 __attribute__((ext_vector_type(8)));
typedef float f32x4 __attribute__((ext_vector_type(4)));
typedef unsigned u32x4 __attribute__((ext_vector_type(4)));
constexpr int BM = 256, BK = 64, HALF = 128, HTB = HALF * BK * 2, STAGE_BYTES = 8 * HTB, NXCD = 8, WGM = 8;

__host__ __device__ __forceinline__ int lds_byte(int r, int c) { const int st = (r >> 4) * 2 + (c >> 5), rr = r & 15, cc = c & 31, ob = rr * 64 + cc * 2; return st * 1024 + (ob ^ (((ob >> 9) & 1) << 5)); }
__host__ __device__ __forceinline__ void stage_rc(int b, int& R, int& C) { const int st = b / 1024, sb = b % 1024, swz = sb ^ (((sb >> 9) & 1) << 5); R = (st >> 1) * 16 + swz / 64; C = (st & 1) * 32 + (swz % 64) / 2; }
__host__ __device__ __forceinline__ int perm32(int rho) { const int n = rho >> 4, i = rho & 15; return 8 * (i >> 2) + 4 * n + (i & 3); }

struct Unit { int pm, pn, pc; };
struct Gemm { const bf16_t* A; const bf16_t* Bt; int M, N, K; };

struct StaticOrder {
    int nM, nN, nwg, G, c;
    __host__ __device__ void init(int M, int N, int G_, int c_) { nM = M / BM; nN = N / BM; nwg = nM * nN; G = G_; c = c_; }
    __host__ __device__ bool next(int i, Unit& u) const {
        const long L = (long)i * G + c; if (L >= nwg) return false;
        int wgid = (int)L; { const int q = nwg / NXCD, r = nwg % NXCD, xcd = wgid % NXCD, off = wgid / NXCD; wgid = (xcd < r ? xcd * (q + 1) : r * (q + 1) + (xcd - r) * q) + off; }
        const int nig = WGM * nN, gid = wgid / nig, fm = gid * WGM, gsz = (nM - fm) < WGM ? (nM - fm) : WGM;
        u.pm = fm + ((wgid % nig) % gsz); u.pn = (wgid % nig) / gsz; u.pc = u.pn; return true;
    }
    __device__ __forceinline__ void a_ready(const Unit&) const {}
    __device__ __forceinline__ void done(const Unit&) const {}
};
struct MoeOrder {
    const int* te; int ntiles, NJ, G, c;
    __device__ bool next(int i, Unit& u) const {
        const long L = (long)i * G + c; if (L >= (long)ntiles * NJ) return false;
        const int tile = (int)L / NJ, j = (int)L % NJ; const int e = te[tile];
        u.pm = tile; u.pn = e * NJ + j; u.pc = j; return true;
    }
    __device__ __forceinline__ void a_ready(const Unit&) const {}
    __device__ __forceinline__ void done(const Unit&) const {}
};

__device__ __forceinline__ unsigned cvt_pk_bf16(float lo, float hi) { unsigned r; asm volatile("v_cvt_pk_bf16_f32 %0, %1, %2" : "=v"(r) : "v"(lo), "v"(hi)); return r; }

template <class Epi, class Sched, bool ALIGN_EPI = false, bool SP2 = false>
__device__ __forceinline__ void gemm_phase(PG8_LAS unsigned char* lds, const Gemm g, const Sched& S, const Epi& E, int tid) {
    asm volatile("" : "+v"(tid));
    const int wid = __builtin_amdgcn_readfirstlane(tid >> 6), lane = tid & 63, wr = wid >> 2, wc = wid & 3, fr = lane & 15, fq = lane >> 4;
    const int K = g.K, nt = K / BK;
    unsigned voffA[2], voffB[2];
#pragma unroll
    for (int i = 0; i < 2; ++i) { int R, C; stage_rc(tid * 16 + i * 8192, R, C); const int Rb = Epi::PERM ? ((R & ~31) + perm32(R & 31)) : R;
        voffA[i] = (unsigned)(R * K + C) * 2u; voffB[i] = (unsigned)(Rb * K + C) * 2u; }
    const size_t kstep = (size_t)(BK * 2);
    const size_t hstep = (size_t)HALF * K * 2;
    const size_t tstep = 2 * hstep;
    const unsigned ldsw = (unsigned)wid * 1024u;
    const int aoff = lds_byte(wr * 64 + fr, fq * 8), boff = lds_byte(wc * 32 + fr, fq * 8);
#define PG8_SA(b, h) (((b) * 2 + (h)) * HTB)
#define PG8_SB(b, h) ((4 + (b) * 2 + (h)) * HTB)
#define PG8_STAGE(bufoff, gbase, voff) do { _Pragma("unroll") for (int _i = 0; _i < 2; ++_i) \
        __builtin_amdgcn_global_load_lds((const unsigned*)((const char*)(gbase) + (voff)[_i]), (PG8_LAS unsigned*)(lds + (bufoff) + ldsw + _i * 8192), 16, 0, 0); } while (0)
#define PG8_LDA(dst, b, h) do { _Pragma("unroll") for (int m = 0; m < 4; ++m) _Pragma("unroll") for (int k = 0; k < 2; ++k) dst[m][k] = *(const PG8_LAS bf16x8*)(lds + PG8_SA(b, h) + aoff + m * 2048 + k * 1024); } while (0)
#define PG8_LDB(dst, b, h) do { _Pragma("unroll") for (int n = 0; n < 2; ++n) _Pragma("unroll") for (int k = 0; k < 2; ++k) dst[n][k] = *(const PG8_LAS bf16x8*)(lds + PG8_SB(b, h) + boff + n * 2048 + k * 1024); } while (0)
#define PG8_MMA(ai, bj, At, Bt) do { __builtin_amdgcn_s_setprio(1); _Pragma("unroll") for (int m = 0; m < 4; ++m) _Pragma("unroll") for (int n = 0; n < 2; ++n) _Pragma("unroll") for (int k = 0; k < 2; ++k) \
        acc[ai][bj][m][n] = __builtin_amdgcn_mfma_f32_16x16x32_bf16(Bt[n][k], At[m][k], acc[ai][bj][m][n], 0, 0, 0); __builtin_amdgcn_s_setprio(0); } while (0)
#define PG8_WAIT_V(n) asm volatile("s_waitcnt vmcnt(" #n ")" ::: "memory")
#define PG8_WAIT_L(n) asm volatile("s_waitcnt lgkmcnt(" #n ")" ::: "memory")
#define PG8_BAR __builtin_amdgcn_s_barrier()
#define PG8_SCHED __builtin_amdgcn_sched_barrier(0)
    Unit cur, nxt; int ui = 0;
    if (!S.next(0, cur)) return;
    f32x4 acc[2][2][4][2];
#pragma unroll
    for (int a = 0; a < 2; ++a)
#pragma unroll
        for (int b = 0; b < 2; ++b)
#pragma unroll
            for (int m = 0; m < 4; ++m)
#pragma unroll
                for (int n = 0; n < 2; ++n) acc[a][b][m][n] = (f32x4){0.f, 0.f, 0.f, 0.f};
    bf16x8 At[4][2], B0[2][2], B1[2][2];
    const char* cA = (const char*)g.A + (size_t)cur.pm * tstep; const char* cB = (const char*)g.Bt + (size_t)cur.pn * tstep;
    S.a_ready(cur);
    if constexpr (SP2) {
        PG8_STAGE(PG8_SB(0, 0), cB, voffB); PG8_STAGE(PG8_SB(0, 1), cB + hstep, voffB); PG8_STAGE(PG8_SA(0, 0), cA, voffA); PG8_STAGE(PG8_SA(0, 1), cA + hstep, voffA);
        if (wr == 1) PG8_BAR;
        PG8_WAIT_V(2); PG8_BAR;
        PG8_STAGE(PG8_SB(1, 0), cB + kstep, voffB); PG8_STAGE(PG8_SA(1, 0), cA + kstep, voffA); PG8_STAGE(PG8_SB(1, 1), cB + hstep + kstep, voffB);
        PG8_WAIT_V(6); PG8_BAR;
    } else {
        PG8_STAGE(PG8_SB(0, 0), cB, voffB); PG8_STAGE(PG8_SA(0, 0), cA, voffA); PG8_STAGE(PG8_SB(0, 1), cB + hstep, voffB); PG8_STAGE(PG8_SA(0, 1), cA + hstep, voffA);
        if (wr == 1) PG8_BAR;
        PG8_WAIT_V(4); PG8_BAR;
        PG8_STAGE(PG8_SB(1, 0), cB + kstep, voffB); PG8_STAGE(PG8_SA(1, 0), cA + kstep, voffA); PG8_STAGE(PG8_SB(1, 1), cB + hstep + kstep, voffB);
        PG8_WAIT_V(6); PG8_BAR;
    }
    for (;;) {
        const bool has_next = S.next(ui + 1, nxt);
        const char* nA = has_next ? (const char*)g.A + (size_t)nxt.pm * tstep : cA; const char* nB = has_next ? (const char*)g.Bt + (size_t)nxt.pn * tstep : cB;
        for (int t = 0; t < nt; t += 2) {
            const bool last = (t == nt - 2);
            const char* a1 = cA + (size_t)(t + 1) * kstep;
            const char* a2 = last ? nA : cA + (size_t)(t + 2) * kstep; const char* b2 = last ? nB : cB + (size_t)(t + 2) * kstep;
            const char* a3 = a2 + kstep; const char* b3 = b2 + kstep;
            if (last && has_next) S.a_ready(nxt);
            if constexpr (SP2) {
            PG8_LDB(B0, 0, 0); PG8_LDB(B1, 0, 1); PG8_SCHED; PG8_LDA(At, 0, 0); PG8_STAGE(PG8_SA(1, 1), a1 + hstep, voffA);
            PG8_WAIT_V(8); PG8_WAIT_L(0); PG8_BAR; PG8_MMA(0, 0, At, B0); PG8_MMA(0, 1, At, B1); PG8_BAR; PG8_SCHED;
            PG8_LDA(At, 0, 1); PG8_STAGE(PG8_SB(0, 0), b2, voffB); PG8_STAGE(PG8_SB(0, 1), b2 + hstep, voffB); PG8_STAGE(PG8_SA(0, 0), a2, voffA);
            PG8_WAIT_V(8); PG8_WAIT_L(0); PG8_BAR; PG8_MMA(1, 0, At, B0); PG8_MMA(1, 1, At, B1); PG8_BAR; PG8_SCHED;
            PG8_LDB(B0, 1, 0); PG8_LDB(B1, 1, 1); PG8_SCHED; PG8_LDA(At, 1, 0); PG8_STAGE(PG8_SA(0, 1), a2 + hstep, voffA);
            PG8_WAIT_V(8); PG8_WAIT_L(0); PG8_BAR; PG8_MMA(0, 0, At, B0); PG8_MMA(0, 1, At, B1); PG8_BAR; PG8_SCHED;
            PG8_LDA(At, 1, 1); PG8_STAGE(PG8_SB(1, 0), b3, voffB); PG8_STAGE(PG8_SB(1, 1), b3 + hstep, voffB); PG8_STAGE(PG8_SA(1, 0), a3, voffA);
            PG8_WAIT_V(8); PG8_WAIT_L(0); PG8_BAR; PG8_MMA(1, 0, At, B0); PG8_MMA(1, 1, At, B1); PG8_BAR; PG8_SCHED;
            } else {
            PG8_LDB(B0, 0, 0); PG8_SCHED; PG8_LDA(At, 0, 0); PG8_STAGE(PG8_SA(1, 1), a1 + hstep, voffA);
            PG8_WAIT_L(8); PG8_BAR; PG8_WAIT_L(0); PG8_MMA(0, 0, At, B0); PG8_BAR; PG8_SCHED;
            PG8_LDB(B1, 0, 1); PG8_STAGE(PG8_SB(0, 0), b2, voffB);
            PG8_BAR; PG8_WAIT_L(0); PG8_MMA(0, 1, At, B1); PG8_BAR;
            PG8_LDA(At, 0, 1); PG8_STAGE(PG8_SA(0, 0), a2, voffA);
            PG8_BAR; PG8_WAIT_L(0); PG8_MMA(1, 0, At, B0); PG8_BAR; PG8_SCHED;
            PG8_STAGE(PG8_SB(0, 1), b2 + hstep, voffB);
            PG8_WAIT_V(6); PG8_BAR; PG8_MMA(1, 1, At, B1); PG8_BAR;
            PG8_LDB(B0, 1, 0); PG8_SCHED; PG8_LDA(At, 1, 0); PG8_STAGE(PG8_SA(0, 1), a2 + hstep, voffA);
            PG8_WAIT_L(8); PG8_BAR; PG8_WAIT_L(0); PG8_MMA(0, 0, At, B0); PG8_BAR; PG8_SCHED;
            PG8_LDB(B1, 1, 1); PG8_STAGE(PG8_SB(1, 0), b3, voffB);
            PG8_BAR; PG8_WAIT_L(0); PG8_MMA(0, 1, At, B1); PG8_BAR;
            PG8_LDA(At, 1, 1); PG8_STAGE(PG8_SA(1, 0), a3, voffA);
            PG8_BAR; PG8_WAIT_L(0); PG8_MMA(1, 0, At, B0); PG8_BAR; PG8_SCHED;
            PG8_STAGE(PG8_SB(1, 1), b3 + hstep, voffB);
            PG8_WAIT_V(6); PG8_BAR; PG8_MMA(1, 1, At, B1); PG8_BAR;
            }
        }
        if constexpr (ALIGN_EPI) { if (wr == 0) PG8_BAR; }
        E(acc, cur, wr, wc, fr, fq); S.done(cur);
        if (!has_next) break;
#pragma unroll
        for (int a = 0; a < 2; ++a)
#pragma unroll
            for (int b = 0; b < 2; ++b)
#pragma unroll
                for (int m = 0; m < 4; ++m)
#pragma unroll
                    for (int n = 0; n < 2; ++n) acc[a][b][m][n] = (f32x4){0.f, 0.f, 0.f, 0.f};
        cur = nxt; cA = nA; cB = nB; ++ui;
        if constexpr (ALIGN_EPI) { if (wr == 1) PG8_BAR; }
    }
    PG8_WAIT_V(0);
    if constexpr (!ALIGN_EPI) { if (wr == 0) PG8_BAR; }
    PG8_BAR;
#undef PG8_SA
#undef PG8_SB
#undef PG8_STAGE
#undef PG8_LDA
#undef PG8_LDB
#undef PG8_MMA
#undef PG8_WAIT_V
#undef PG8_WAIT_L
#undef PG8_BAR
#undef PG8_SCHED
}
}

constexpr int NWAVES = 8;
constexpr int D_MODEL = 2048, BATCH = 4, SEQ = 2048, DEPTH = 4, NTOK = BATCH * SEQ;
constexpr int SSMW = 1024, CONVW = 1024, NGRP = 64, CH = 16, NST = 64, INW = 3072, CONV_K = 31;
constexpr int NEG = 4, EPG = 8, NEXP = 32, EH = 256, PLE = 256;
constexpr int SROWS = 24576;
constexpr int MAXTILES = SROWS / 256;
constexpr float ALPHA = 1.681792830507429f;
constexpr float LN_EPS = 1e-5f;

constexpr int PH_PER_LAYER = 11, NPHASES = 1 + PH_PER_LAYER * DEPTH;

constexpr size_t MiB = 1u << 20;
constexpr size_t WS_CTL = 0, CTL_ZERO_BYTES = 1 * MiB;
constexpr size_t WS_W0 = 1 * MiB, W_LAYER = 128 * MiB;
constexpr size_t WO_IN = 0, WO_GLU = 12 * MiB, WO_O = 14 * MiB, WO_GU = 22 * MiB, WO_D = 86 * MiB, WO_PG = 118 * MiB, WO_P = 126 * MiB, WO_R = 127 * MiB;
constexpr size_t WS_ACT = WS_W0 + DEPTH * W_LAYER;
constexpr size_t WS_XB = WS_ACT, WS_PB = WS_XB + 32 * MiB, WS_U = WS_PB + 16 * MiB, WS_HC = WS_U + 16 * MiB, WS_Z = WS_HC + 16 * MiB, WS_MIX = WS_Z + 16 * MiB,
                 WS_V = WS_MIX + 32 * MiB, WS_H1 = WS_V + 64 * MiB, WS_XS = WS_H1 + 32 * MiB, WS_HS = WS_XS + 96 * MiB, WS_H2 = WS_HS + 12 * MiB, WS_E1 = WS_H2 + 32 * MiB,
                 WS_ROWW = WS_E1 + 32 * MiB, WS_TOK = WS_ROWW + 1 * MiB, WS_END = WS_TOK + 1 * MiB;
constexpr int CW_TMO = 0, CW_BAR = 4096, CW_CNT = 8192  , CW_DBG = 12288  , CW_NT = 16384  , CW_TE = 20480  ;

constexpr int RING_BYTES = 139264;
constexpr int MISC_OFF = RING_BYTES;
constexpr int LDS_BYTES = 147456;

#define GAS __attribute__((address_space(1)))
#define LAS __attribute__((address_space(3)))
typedef unsigned short bf16;
typedef unsigned v4u __attribute__((ext_vector_type(4)));
typedef unsigned v2u __attribute__((ext_vector_type(2)));
typedef float f32x4 __attribute__((ext_vector_type(4)));
typedef float f32x2 __attribute__((ext_vector_type(2)));
typedef short bf16x8 __attribute__((ext_vector_type(8)));
#define LDS_WAIT() asm volatile("s_waitcnt lgkmcnt(0)" ::: "memory")
#define VM_WAIT() asm volatile("s_waitcnt vmcnt(0)" ::: "memory")
__device__ __forceinline__ float bflo(unsigned w) { return __uint_as_float(w << 16); }
__device__ __forceinline__ float bfhi(unsigned w) { return __uint_as_float(w & 0xffff0000u); }
__device__ __forceinline__ float bf2f(bf16 b) { return __uint_as_float((unsigned)b << 16); }
__device__ __forceinline__ unsigned f2bf(float f) { unsigned u = __float_as_uint(f); return (u + 0x7fffu + ((u >> 16) & 1u)) >> 16; }
__device__ __forceinline__ unsigned pk2(float lo, float hi) { return pg8::cvt_pk_bf16(lo, hi); }
__device__ __forceinline__ float sigm(float x) { return __builtin_amdgcn_rcpf(1.f + __expf(-x)); }
__device__ __forceinline__ float silu_f(float x) { return x * sigm(x); }
__device__ __forceinline__ float gelu_tanh(float y) { const float x = 0.7978845608028654f * (y + 0.044715f * y * y * y); const float t = 1.f - 2.f * __builtin_amdgcn_rcpf(1.f + __expf(2.f * x)); return 0.5f * y * (1.f + t); }
__device__ __forceinline__ void unpack8(const v4u w, float (&f)[8]) { f[0] = bflo(w.x); f[1] = bfhi(w.x); f[2] = bflo(w.y); f[3] = bfhi(w.y); f[4] = bflo(w.z); f[5] = bfhi(w.z); f[6] = bflo(w.w); f[7] = bfhi(w.w); }
__device__ __forceinline__ v4u pack8(const float (&f)[8]) { v4u w; w.x = pk2(f[0], f[1]); w.y = pk2(f[2], f[3]); w.z = pk2(f[4], f[5]); w.w = pk2(f[6], f[7]); return w; }
template <int X> __device__ __forceinline__ float swz_xor(float v) { return __int_as_float(__builtin_amdgcn_ds_swizzle(__float_as_int(v), (X << 10) | 0x1f)); }
__device__ __forceinline__ float wave_sum(float v) {
    v += swz_xor<1>(v); v += swz_xor<2>(v); v += swz_xor<4>(v); v += swz_xor<8>(v); v += swz_xor<16>(v);
    return __int_as_float(__builtin_amdgcn_readlane(__float_as_int(v), 0)) + __int_as_float(__builtin_amdgcn_readlane(__float_as_int(v), 32));
}

#define XB_TMO      128
#define XB_XCNT(j)  (256  + 64 * (j))
#define XB_XSUB(j)  (1280 + 64 * (j))
#define XB_XGEN(j)  (2304 + 64 * (j))
#define XB_TOP      3328
#define XB_TOPGEN   3392
#define XCD_BAR_WORDS 3456
#define XB_SPIN_CAP (1u << 18)
__device__ __forceinline__ unsigned xb_ld(unsigned* p)              { return __hip_atomic_load(p, __ATOMIC_RELAXED, __HIP_MEMORY_SCOPE_AGENT); }
__device__ __forceinline__ unsigned xb_add(unsigned* p, unsigned v) { return __hip_atomic_fetch_add(p, v, __ATOMIC_RELAXED, __HIP_MEMORY_SCOPE_AGENT); }
__device__ __forceinline__ unsigned xb_xcc_id() { return (unsigned)__builtin_amdgcn_s_getreg((3 << 11) | 20) & 0xFu; }
#define XB_SPIN(cond, bar) do { unsigned _sp = 0; while (cond) { __builtin_amdgcn_s_sleep(1); \
    if ((++_sp & 255u) == 0u) { if (xb_ld(&(bar)[XB_TMO])) break; if (_sp > XB_SPIN_CAP) { atomicAdd(&(bar)[XB_TMO], 1u); break; } } } } while (0)
struct XcdBarrier { unsigned* bar; unsigned x; volatile LAS unsigned* st; };
__device__ __forceinline__ XcdBarrier xcd_barrier_post(unsigned* bar, volatile LAS unsigned* st) {
    XcdBarrier b; b.bar = bar; b.x = xb_xcc_id(); b.st = st;
    if (threadIdx.x == 0) (void)xb_add(&bar[XB_XCNT(b.x)], 1u);
    return b;
}
__device__ __forceinline__ void xcd_barrier_complete(unsigned* bar, unsigned x, unsigned& nloc, unsigned& nx) {
    const unsigned G = gridDim.x * gridDim.y * gridDim.z;
    unsigned sum, cnt, mine, sp = 0u;
    for (;;) {
        sum = 0u; cnt = 0u; mine = 0u;
#pragma unroll
        for (unsigned j = 0; j < 16; ++j) { const unsigned c = xb_ld(&bar[XB_XCNT(j)]); sum += c; cnt += (c > 0u) ? 1u : 0u; mine = (j == x) ? c : mine; }
        if (sum == G) break;
        __builtin_amdgcn_s_sleep(1);
        if ((++sp & 255u) == 0u) { if (xb_ld(&bar[XB_TMO])) break; if (sp > XB_SPIN_CAP) { atomicAdd(&bar[XB_TMO], 1u); break; } }
    }
    nloc = mine > 0u ? mine : 1u; nx = cnt > 0u ? cnt : 1u;
}
__device__ __forceinline__ void xcd_barrier(const XcdBarrier& b) {
    asm volatile("s_waitcnt vmcnt(0)" ::: "memory");
    __syncthreads();
    if (threadIdx.x == 0) {
        unsigned* bar = b.bar;
        __builtin_amdgcn_s_waitcnt(0);
        unsigned nloc = b.st[0], nx = b.st[1];
        if (nloc == 0u) { xcd_barrier_complete(bar, b.x, nloc, nx); b.st[0] = nloc; b.st[1] = nx; }
        const unsigned old = xb_add(&bar[XB_XSUB(b.x)], 1u);
        const unsigned gen = old / nloc;
        if (old + 1u == (gen + 1u) * nloc) {
            __builtin_amdgcn_fence(__ATOMIC_RELEASE, "agent");
            asm volatile("s_waitcnt vmcnt(0)" ::: "memory");
            const unsigned og = xb_add(&bar[XB_TOP], 1u);
            const unsigned tg = og / nx;
            if (og + 1u == (tg + 1u) * nx) xb_add(&bar[XB_TOPGEN], 1u);
            else XB_SPIN(xb_ld(&bar[XB_TOPGEN]) == tg, bar);
            __builtin_amdgcn_fence(__ATOMIC_ACQUIRE, "agent");
            xb_add(&bar[XB_XGEN(b.x)], 1u);
            asm volatile("s_waitcnt vmcnt(0)" ::: "memory");
        } else {
            XB_SPIN(xb_ld(&bar[XB_XGEN(b.x)]) == gen, bar);
            __builtin_amdgcn_fence(__ATOMIC_ACQUIRE, "agent");
            asm volatile("s_waitcnt vmcnt(0)" ::: "memory");
        }
    }
    __syncthreads();
}

struct Args { const float* in[36]; float* out; unsigned char* ws; int ph_lo, ph_hi; };
enum { I_X = 0, I_P, I_WIN, I_BIN, I_LAMRE, I_LAMIM, I_LOGDT, I_BRE, I_BIM, I_CRE, I_CIM, I_SSMD, I_WGLU, I_BGLU, I_WDW, I_BDW, I_CLNG, I_CLNB, I_WO, I_BO, I_LN1G, I_LN1B,
       I_WRG, I_BRG, I_WRE, I_BRE2, I_WGATE, I_WUP, I_WDOWN, I_LN2G, I_LN2B, I_WP, I_WPG, I_BPG, I_LN3G, I_LN3B };
struct Frame {
    LAS unsigned char* lds;
    int tid, lane, wave, blk, G;
    int z;
    const float* const* in; float* out; unsigned char* ws;
};
__device__ __forceinline__ const float* inp(const Frame& F, int i) { return F.in[i + F.z]; }
__device__ __forceinline__ unsigned char* wsp(const Frame& F, size_t off) { return F.ws + (off + (size_t)(unsigned)F.z); }
__device__ __forceinline__ bf16* wsb(const Frame& F, size_t off) { return (bf16*)wsp(F, off); }
__device__ __forceinline__ bf16* wlayer(const Frame& F, int l, size_t off) { return (bf16*)wsp(F, WS_W0 + (size_t)l * W_LAYER + off); }
__device__ __forceinline__ unsigned* ctlw(const Frame& F) { return (unsigned*)wsp(F, WS_CTL); }

using pg8::Unit; using pg8::HALF; using pg8::BM;
__device__ __forceinline__ v4u ld16(const void* base, unsigned boff) { return *(const v4u*)((const char*)base + boff); }
__device__ __forceinline__ void st16(void* base, unsigned boff, v4u v) { *(v4u*)((char*)base + boff) = v; }
__device__ __forceinline__ f32x4 ldf4(const void* base, unsigned boff) { return *(const f32x4*)((const char*)base + boff); }
__device__ __forceinline__ void stf4(void* base, unsigned boff, f32x4 v) { *(f32x4*)((char*)base + boff) = v; }
#define EPI_PIN() asm volatile("" : "+v"(fr), "+v"(fq))
struct EpiIn {
    static constexpr bool PERM = true;
    bf16* U; bf16* HC; const float* bias;
    __device__ __forceinline__ void operator()(const f32x4 (&acc)[2][2][4][2], const Unit& u, int wr, int wc, int fr, int fq) const {
        EPI_PIN();
        const unsigned row0 = u.pm * BM + wr * 64 + fr, cl = wc * 32 + 8 * fq;
        if (u.pn < 4) {
            f32x4 bv[2][2];
#pragma unroll
            for (int bj = 0; bj < 2; ++bj)
#pragma unroll
                for (int n = 0; n < 2; ++n) bv[bj][n] = ldf4(bias, (u.pn * BM + bj * HALF + cl + 4 * n) * 4u);
#pragma unroll
            for (int ai = 0; ai < 2; ++ai)
#pragma unroll
                for (int m = 0; m < 4; ++m) { const unsigned off = ((row0 + ai * HALF + m * 16) * SSMW + u.pn * BM + cl) * 2u;
#pragma unroll
                    for (int bj = 0; bj < 2; ++bj) { const f32x4 v0 = acc[ai][bj][m][0] + bv[bj][0], v1 = acc[ai][bj][m][1] + bv[bj][1];
                        v4u w; w.x = pk2(v0[0], v0[1]); w.y = pk2(v0[2], v0[3]); w.z = pk2(v1[0], v1[1]); w.w = pk2(v1[2], v1[3]);
                        st16(U, off + bj * HALF * 2u, w); } }
        } else {
            const unsigned chn = (u.pn - 4) * HALF + cl;
            f32x4 bvv[2], bgg[2];
#pragma unroll
            for (int n = 0; n < 2; ++n) { bvv[n] = ldf4(bias, (SSMW + chn + 4 * n) * 4u); bgg[n] = ldf4(bias, (SSMW + CONVW + chn + 4 * n) * 4u); }
#pragma unroll
            for (int ai = 0; ai < 2; ++ai)
#pragma unroll
                for (int m = 0; m < 4; ++m) { const unsigned off = ((row0 + ai * HALF + m * 16) * CONVW + chn) * 2u;
                    float o[8];
#pragma unroll
                    for (int n = 0; n < 2; ++n) { const f32x4 vv = acc[ai][0][m][n] + bvv[n], gg = acc[ai][1][m][n] + bgg[n];
#pragma unroll
                        for (int j = 0; j < 4; ++j) o[4 * n + j] = vv[j] * sigm(gg[j]); }
                    st16(HC, off, pack8(o)); }
        }
    }
};
struct EpiGlu {
    static constexpr bool PERM = true;
    const bf16* Z; bf16* MIX; const float* bias;
    __device__ __forceinline__ void operator()(const f32x4 (&acc)[2][2][4][2], const Unit& u, int wr, int wc, int fr, int fq) const {
        EPI_PIN();
        const unsigned row0 = u.pm * BM + wr * 64 + fr, col0 = u.pc * BM + wc * 32 + 8 * fq;
        f32x4 bv[2][2];
#pragma unroll
        for (int bj = 0; bj < 2; ++bj)
#pragma unroll
            for (int n = 0; n < 2; ++n) bv[bj][n] = ldf4(bias, (col0 + bj * HALF + 4 * n) * 4u);
#pragma unroll
        for (int ai = 0; ai < 2; ++ai)
#pragma unroll
            for (int m = 0; m < 4; ++m) { const unsigned row = row0 + ai * HALF + m * 16;
#pragma unroll
                for (int bj = 0; bj < 2; ++bj) { const unsigned col = col0 + bj * HALF;
                    float zf[8]; unpack8(ld16(Z, (row * SSMW + col) * 2u), zf);
                    const f32x4 v0 = acc[ai][bj][m][0] + bv[bj][0], v1 = acc[ai][bj][m][1] + bv[bj][1];
                    float o[8];
#pragma unroll
                    for (int j = 0; j < 4; ++j) { o[j] = zf[j] * sigm(v0[j]); o[4 + j] = zf[4 + j] * sigm(v1[j]); }
                    st16(MIX, (row * D_MODEL + col) * 2u, pack8(o)); }
                asm volatile("" ::: "memory"); }
    }
};
struct EpiPlain {
    static constexpr bool PERM = true;
    bf16* O; int ldc;
    __device__ __forceinline__ void operator()(const f32x4 (&acc)[2][2][4][2], const Unit& u, int wr, int wc, int fr, int fq) const {
        EPI_PIN();
        const unsigned row0 = u.pm * BM + wr * 64 + fr, col0 = u.pc * BM + wc * 32 + 8 * fq;
#pragma unroll
        for (int ai = 0; ai < 2; ++ai)
#pragma unroll
            for (int m = 0; m < 4; ++m) { const unsigned off = ((row0 + ai * HALF + m * 16) * (unsigned)ldc + col0) * 2u;
#pragma unroll
                for (int bj = 0; bj < 2; ++bj) { const f32x4 v0 = acc[ai][bj][m][0], v1 = acc[ai][bj][m][1];
                    v4u w; w.x = pk2(v0[0], v0[1]); w.y = pk2(v0[2], v0[3]); w.z = pk2(v1[0], v1[1]); w.w = pk2(v1[2], v1[3]);
                    st16(O, off + bj * HALF * 2u, w); } }
    }
};
struct EpiOut {
    static constexpr bool PERM = true;
    const bf16* XB; float* V; const float* bias;
    __device__ __forceinline__ void operator()(const f32x4 (&acc)[2][2][4][2], const Unit& u, int wr, int wc, int fr, int fq) const {
        EPI_PIN();
        const unsigned row0 = u.pm * BM + wr * 64 + fr, col0 = u.pc * BM + wc * 32 + 8 * fq;
        f32x4 bv[2][2];
#pragma unroll
        for (int bj = 0; bj < 2; ++bj)
#pragma unroll
            for (int n = 0; n < 2; ++n) bv[bj][n] = ldf4(bias, (col0 + bj * HALF + 4 * n) * 4u);
#pragma unroll
        for (int ai = 0; ai < 2; ++ai)
#pragma unroll
            for (int m = 0; m < 4; ++m) { const unsigned eoff = (row0 + ai * HALF + m * 16) * D_MODEL + col0;
#pragma unroll
                for (int bj = 0; bj < 2; ++bj) { float xf[8]; unpack8(ld16(XB, (eoff + bj * HALF) * 2u), xf);
                    f32x4 o0 = acc[ai][bj][m][0] + bv[bj][0], o1 = acc[ai][bj][m][1] + bv[bj][1];
#pragma unroll
                    for (int j = 0; j < 4; ++j) { o0[j] += ALPHA * xf[j]; o1[j] += ALPHA * xf[4 + j]; }
                    stf4(V, (eoff + bj * HALF) * 4u, o0); stf4(V, (eoff + bj * HALF + 4) * 4u, o1); }
                asm volatile("" ::: "memory"); }
    }
};
struct EpiMoeUp {
    static constexpr bool PERM = true;
    bf16* HS; const float* roww;
    __device__ __forceinline__ void operator()(const f32x4 (&acc)[2][2][4][2], const Unit& u, int wr, int wc, int fr, int fq) const {
        EPI_PIN();
        const unsigned row0 = u.pm * BM + wr * 64 + fr, cl = u.pc * HALF + wc * 32 + 8 * fq;
#pragma unroll
        for (int ai = 0; ai < 2; ++ai)
#pragma unroll
            for (int m = 0; m < 4; ++m) { const unsigned row = row0 + ai * HALF + m * 16; const float rw = *(const float*)((const char*)roww + row * 4u);
                float o[8];
#pragma unroll
                for (int n = 0; n < 2; ++n) { const f32x4 gg = acc[ai][0][m][n], uu = acc[ai][1][m][n];
#pragma unroll
                    for (int j = 0; j < 4; ++j) o[4 * n + j] = silu_f(gg[j]) * uu[j] * rw; }
                st16(HS, (row * EH + cl) * 2u, pack8(o)); }
    }
};
struct EpiGate {
    static constexpr bool PERM = true;
    const bf16* H2; const bf16* E1; float* V; const float* bias;
    __device__ __forceinline__ void operator()(const f32x4 (&acc)[2][2][4][2], const Unit& u, int wr, int wc, int fr, int fq) const {
        EPI_PIN();
        const unsigned row0 = u.pm * BM + wr * 64 + fr, col0 = u.pc * BM + wc * 32 + 8 * fq;
        f32x4 bv[2][2];
#pragma unroll
        for (int bj = 0; bj < 2; ++bj)
#pragma unroll
            for (int n = 0; n < 2; ++n) bv[bj][n] = ldf4(bias, (col0 + bj * HALF + 4 * n) * 4u);
#pragma unroll
        for (int ai = 0; ai < 2; ++ai)
#pragma unroll
            for (int m = 0; m < 4; ++m) { const unsigned eoff = (row0 + ai * HALF + m * 16) * D_MODEL + col0;
#pragma unroll
                for (int bj = 0; bj < 2; ++bj) { float hf[8], ef[8]; unpack8(ld16(H2, (eoff + bj * HALF) * 2u), hf); unpack8(ld16(E1, (eoff + bj * HALF) * 2u), ef);
                    const f32x4 a0 = acc[ai][bj][m][0] + bv[bj][0], a1 = acc[ai][bj][m][1] + bv[bj][1]; f32x4 o0, o1;
#pragma unroll
                    for (int j = 0; j < 4; ++j) { o0[j] = ALPHA * hf[j] + ef[j] * sigm(a0[j]); o1[j] = ALPHA * hf[4 + j] + ef[4 + j] * sigm(a1[j]); }
                    stf4(V, (eoff + bj * HALF) * 4u, o0); stf4(V, (eoff + bj * HALF + 4) * 4u, o1); }
                asm volatile("" ::: "memory"); }
    }
};

__device__ __forceinline__ void transpose_tile(const float* src, int ldn, int k0, int n0, bf16* dst, size_t drow0, int ldk, LAS float* scr, int lane) {
    const int lr = lane >> 4, lc = (lane & 15) * 4;
#pragma unroll 4
    for (int i = 0; i < 16; ++i) { const int kk = 4 * i + lr; const f32x4 v = *(const f32x4*)(src + (size_t)(k0 + kk) * ldn + n0 + lc);
        LAS float* s = scr + kk * 65 + lc; s[0] = v[0]; s[1] = v[1]; s[2] = v[2]; s[3] = v[3]; }
    LDS_WAIT(); asm volatile("" ::: "memory");
    const int kc = lane & 7;
#pragma unroll 2
    for (int j = 0; j < 8; ++j) { const int n = (lane >> 3) + 8 * j; const LAS float* s = scr + (8 * kc) * 65 + n;
        v4u o; o.x = pk2(s[0], s[65]); o.y = pk2(s[2 * 65], s[3 * 65]); o.z = pk2(s[4 * 65], s[5 * 65]); o.w = pk2(s[6 * 65], s[7 * 65]);
        *(v4u*)(dst + (drow0 + n) * (size_t)ldk + k0 + 8 * kc) = o; }
    LDS_WAIT(); asm volatile("" ::: "memory");
}
__device__ __forceinline__ void p_prologue(Frame& F) {
    LAS float* scr = (LAS float*)(F.lds + F.wave * 16640);
    const int gw = F.blk * NWAVES + F.wave, NGW = F.G * NWAVES;
    constexpr int T_IN = 32 * 48, T_GLU = 16 * 16, T_O = 32 * 32, T_G = 32 * 128, T_D = 32 * 128, T_PG = 32 * 32, T_P = 4 * 32;
    constexpr int T_LAYER = T_IN + T_GLU + T_O + 2 * T_G + T_D + T_PG + T_P;
    for (int it = gw; it < T_LAYER * DEPTH; it += NGW) {
        const int l = it / T_LAYER; int r = it % T_LAYER;
        if (r < T_IN) { const int kt = r / 48, ntl = r % 48, n0 = 64 * ntl; int dr;
            if (n0 < SSMW) dr = n0; else { const int q = n0 - SSMW, part = q / CONVW, cc = q % CONVW; dr = SSMW + (cc / 128) * 256 + part * 128 + (cc % 128); }
            transpose_tile(inp(F, I_WIN) + (size_t)l * D_MODEL * INW, INW, 64 * kt, n0, wlayer(F, l, WO_IN), dr, D_MODEL, scr, F.lane); continue; } r -= T_IN;
        if (r < T_GLU) { const int kt = r / 16, ntl = r % 16;
            transpose_tile(inp(F, I_WGLU) + (size_t)l * SSMW * SSMW, SSMW, 64 * kt, 64 * ntl, wlayer(F, l, WO_GLU), 64 * ntl, SSMW, scr, F.lane); continue; } r -= T_GLU;
        if (r < T_O) { const int kt = r / 32, ntl = r % 32;
            transpose_tile(inp(F, I_WO) + (size_t)l * D_MODEL * D_MODEL, D_MODEL, 64 * kt, 64 * ntl, wlayer(F, l, WO_O), 64 * ntl, D_MODEL, scr, F.lane); continue; } r -= T_O;
        if (r < 2 * T_G) { const int up = r / T_G; const int rr = r % T_G; const int e = rr / 128, q = rr % 128, kt = q / 4, ntl = q % 4, n0 = 64 * ntl;
            const float* src = inp(F, up ? I_WUP : I_WGATE) + ((size_t)(l * NEXP + e) * D_MODEL) * EH;
            transpose_tile(src, EH, 64 * kt, n0, wlayer(F, l, WO_GU), (size_t)e * 512 + (n0 / 128) * 256 + up * 128 + (n0 % 128), D_MODEL, scr, F.lane); continue; } r -= 2 * T_G;
        if (r < T_D) { const int e = r / 128, q = r % 128, kt = q / 32, ntl = q % 32;
            const float* src = inp(F, I_WDOWN) + ((size_t)(l * NEXP + e) * EH) * D_MODEL;
            transpose_tile(src, D_MODEL, 64 * kt, 64 * ntl, wlayer(F, l, WO_D), (size_t)e * D_MODEL + 64 * ntl, EH, scr, F.lane); continue; } r -= T_D;
        if (r < T_PG) { const int kt = r / 32, ntl = r % 32;
            transpose_tile(inp(F, I_WPG) + (size_t)l * D_MODEL * D_MODEL, D_MODEL, 64 * kt, 64 * ntl, wlayer(F, l, WO_PG), 64 * ntl, D_MODEL, scr, F.lane); continue; } r -= T_PG;
        { const int kt = r / 32, ntl = r % 32;
            transpose_tile(inp(F, I_WP) + (size_t)l * PLE * D_MODEL, D_MODEL, 64 * kt, 64 * ntl, wlayer(F, l, WO_P), 64 * ntl, PLE, scr, F.lane); }
    }
    const int gt = F.blk * (NWAVES * 64) + F.tid, NGT = F.G * NWAVES * 64;
    for (int i = gt; i < DEPTH * 48 * D_MODEL; i += NGT) { const int l = i / (48 * D_MODEL), q = i % (48 * D_MODEL), n = q / D_MODEL, k = q % D_MODEL;
        float v = 0.f; if (n < NEG) v = inp(F, I_WRG)[((size_t)l * D_MODEL + k) * NEG + n]; else if (n < NEG + NEXP) v = inp(F, I_WRE)[((size_t)l * D_MODEL + k) * NEXP + (n - NEG)];
        wlayer(F, l, WO_R)[(size_t)n * D_MODEL + k] = (bf16)f2bf(v); }
    { const f32x4* xs = (const f32x4*)inp(F, I_X); v4u* xd = (v4u*)wsb(F, WS_XB);
      for (int i = gt; i < NTOK * D_MODEL / 8; i += NGT) { const f32x4 a = xs[2 * i], b = xs[2 * i + 1]; v4u w; w.x = pk2(a[0], a[1]); w.y = pk2(a[2], a[3]); w.z = pk2(b[0], b[1]); w.w = pk2(b[2], b[3]); xd[i] = w; }
      const f32x4* ps = (const f32x4*)inp(F, I_P); v4u* pd = (v4u*)wsb(F, WS_PB);
      for (int i = gt; i < DEPTH * NTOK * PLE / 8; i += NGT) { const f32x4 a = ps[2 * i], b = ps[2 * i + 1]; v4u w; w.x = pk2(a[0], a[1]); w.y = pk2(a[2], a[3]); w.z = pk2(b[0], b[1]); w.w = pk2(b[2], b[3]); pd[i] = w; } }
}

constexpr int BU_PITCH = 132;
constexpr int SB_PITCH = 272;
template <bool OUT> __device__ __forceinline__ void scan_sub(LAS float* BUf, LAS unsigned char* Sb, const bf16x8 (&Xf)[8], const bf16x8 (&Cf)[4], const bf16x8 Df, const bf16x8 Uf,
                                                            const float lbr, const float lbi, float& sr, float& si, const int lane, const int fr, const int kq, char* zp) {
    f32x4 a[8];
#pragma unroll
    for (int jt = 0; jt < 8; ++jt) a[jt] = __builtin_amdgcn_mfma_f32_16x16x32_bf16(Xf[jt], Uf, (f32x4){0.f, 0.f, 0.f, 0.f}, 0, 0, 0);
#pragma unroll
    for (int jt = 0; jt < 8; ++jt) *(LAS f32x4*)(BUf + fr * BU_PITCH + 16 * jt + 4 * kq) = a[jt];
    LDS_WAIT(); __builtin_amdgcn_wave_barrier(); asm volatile("" ::: "memory");
    float br[16], bi[16];
#pragma unroll
    for (int t = 0; t < 16; ++t) { br[t] = BUf[t * BU_PITCH + lane]; bi[t] = BUf[t * BU_PITCH + 64 + lane]; }
    unsigned sp[16];
#pragma unroll
    for (int t = 0; t < 16; ++t) { const float nr = fmaf(lbr, sr, fmaf(-lbi, si, br[t])), ni = fmaf(lbr, si, fmaf(lbi, sr, bi[t])); sr = nr; si = ni; if (OUT) sp[t] = pk2(sr, si); }
    if (OUT) {
#pragma unroll
        for (int t = 0; t < 16; ++t) *(LAS unsigned*)(Sb + t * SB_PITCH + 4 * lane) = sp[t];
        LDS_WAIT(); __builtin_amdgcn_wave_barrier(); asm volatile("" ::: "memory");
        bf16x8 Sf[4];
#pragma unroll
        for (int kk = 0; kk < 4; ++kk) Sf[kk] = *(const LAS bf16x8*)(Sb + fr * SB_PITCH + (32 * kk + 8 * kq) * 2);
        f32x4 y = __builtin_amdgcn_mfma_f32_16x16x32_bf16(Df, Uf, (f32x4){0.f, 0.f, 0.f, 0.f}, 0, 0, 0);
#pragma unroll
        for (int kk = 0; kk < 4; ++kk) y = __builtin_amdgcn_mfma_f32_16x16x32_bf16(Cf[kk], Sf[kk], y, 0, 0, 0);
        v2u o; o.x = pk2(gelu_tanh(y[0]), gelu_tanh(y[1])); o.y = pk2(gelu_tanh(y[2]), gelu_tanh(y[3]));
        *(v2u*)zp = o;
    }
    LDS_WAIT(); __builtin_amdgcn_wave_barrier(); asm volatile("" ::: "memory");
}
__device__ __forceinline__ void scan_item(Frame& F, int l, int item) {
    const int b = item >> 6, g = item & 63, lane = F.lane, w = F.wave;
    LAS float* BUf = (LAS float*)(F.lds + w * 12800);
    LAS unsigned char* Sb = F.lds + w * 12800 + 8448;
    LAS f32x2* coefT = (LAS f32x2*)(F.lds + 102400);
    LAS f32x2* Ebuf = (LAS f32x2*)(F.lds + 102400 + 512);
    const int lg = l * NGRP + g;
    const float dt = expf(inp(F, I_LOGDT)[lg]);
    const float lre = fminf(inp(F, I_LAMRE)[lg * NST + lane], -1e-4f), lim = inp(F, I_LAMIM)[lg * NST + lane];
    const float mag = expf(lre * dt); float sn, cs; sincosf(lim * dt, &sn, &cs);
    const float lbr = mag * cs, lbi = mag * sn;
    { const float nr = lbr - 1.f, ni = lbi, den = lre * lre + lim * lim; coefT[lane] = (f32x2){(nr * lre + ni * lim) / den, (ni * lre - nr * lim) / den}; }
    float l2r = lbr, l2i = lbi;
#pragma unroll
    for (int i = 0; i < 8; ++i) { const float tr = l2r * l2r - l2i * l2i, ti = 2.f * l2r * l2i; l2r = tr; l2i = ti; }
    LDS_WAIT(); __builtin_amdgcn_wave_barrier(); asm volatile("" ::: "memory");
    __syncthreads();
    const int fr = lane & 15, kq = lane >> 4;
    bf16x8 Xf[8];
#pragma unroll
    for (int jt = 0; jt < 8; ++jt) { const int pc = (16 * jt + fr) & 63; const f32x2 cf = coefT[pc]; v4u wv = (v4u){0u, 0u, 0u, 0u};
        if (kq < 2) { const float* bre = inp(F, I_BRE) + ((size_t)lg * NST + pc) * CH + 8 * kq; const float* bim = inp(F, I_BIM) + ((size_t)lg * NST + pc) * CH + 8 * kq; float o[8];
#pragma unroll
            for (int j = 0; j < 8; ++j) { const float br = bre[j], bi = bim[j]; o[j] = (jt < 4) ? (cf.x * br - cf.y * bi) : (cf.x * bi + cf.y * br); }
            wv = pack8(o); }
        Xf[jt] = __builtin_bit_cast(bf16x8, wv); }
    bf16x8 Cf[4];
#pragma unroll
    for (int kk = 0; kk < 4; ++kk) { const float* cre = inp(F, I_CRE) + ((size_t)lg * CH + fr) * NST + 16 * kk + 4 * kq; const float* cim = inp(F, I_CIM) + ((size_t)lg * CH + fr) * NST + 16 * kk + 4 * kq; float o[8];
#pragma unroll
        for (int j = 0; j < 4; ++j) { o[2 * j] = cre[j]; o[2 * j + 1] = -cim[j]; }
        Cf[kk] = __builtin_bit_cast(bf16x8, pack8(o)); }
    bf16x8 Df;
    { const float dh = inp(F, I_SSMD)[(size_t)l * SSMW + g * CH + fr]; float o[8];
#pragma unroll
      for (int j = 0; j < 8; ++j) o[j] = (kq < 2 && 8 * kq + j == fr) ? dh : 0.f;
      Df = __builtin_bit_cast(bf16x8, pack8(o)); }
    const bf16* Ub = wsb(F, WS_U); bf16* Zb = wsb(F, WS_Z);
    const unsigned tok0 = (unsigned)b * SEQ + 256 * w;
    v4u Uw[16];
#pragma unroll
    for (int sc = 0; sc < 16; ++sc) { Uw[sc] = (v4u){0u, 0u, 0u, 0u}; if (kq < 2) Uw[sc] = *(const v4u*)((const char*)Ub + ((tok0 + 16 * sc + fr) * SSMW + g * CH + 8 * kq) * 2u); }
    float sr = 0.f, si = 0.f;
#pragma unroll
    for (int sc = 0; sc < 16; ++sc) scan_sub<false>(BUf, Sb, Xf, Cf, Df, __builtin_bit_cast(bf16x8, Uw[sc]), lbr, lbi, sr, si, lane, fr, kq, nullptr);
    Ebuf[w * 64 + lane] = (f32x2){sr, si};
    LDS_WAIT(); __syncthreads();
    { float cr = 0.f, ci = 0.f;
      for (int j = 0; j < w; ++j) { const f32x2 e = Ebuf[j * 64 + lane]; const float nr = l2r * cr - l2i * ci + e.x, ni = l2r * ci + l2i * cr + e.y; cr = nr; ci = ni; }
      sr = cr; si = ci; }
#pragma unroll
    for (int sc = 0; sc < 16; ++sc) scan_sub<true>(BUf, Sb, Xf, Cf, Df, __builtin_bit_cast(bf16x8, Uw[sc]), lbr, lbi, sr, si, lane, fr, kq, (char*)Zb + ((tok0 + 16 * sc + fr) * SSMW + g * CH + 4 * kq) * 2u);
    __syncthreads();
}

__device__ __forceinline__ void p_conv(Frame& F, int l, int c0, int cs) {
    const int tid = F.tid; const unsigned c2 = 2 * tid;
    const bf16* HC = wsb(F, WS_HC); bf16* MIX = wsb(F, WS_MIX);
    LAS float* P = (LAS float*)F.lds;
    LAS float* ST = (LAS float*)(F.lds + 65536);
    f32x2 wt[CONV_K];
    { const float* wdw = inp(F, I_WDW) + (size_t)l * CONV_K * CONVW + c2;
#pragma unroll
      for (int j = 0; j < CONV_K; ++j) wt[j] = *(const f32x2*)(wdw + (size_t)j * CONVW); }
    const f32x2 bdw = *(const f32x2*)(inp(F, I_BDW) + (size_t)l * CONVW + c2);
    const f32x2 gg = *(const f32x2*)(inp(F, I_CLNG) + (size_t)l * CONVW + c2), bb = *(const f32x2*)(inp(F, I_CLNB) + (size_t)l * CONVW + c2);
#pragma unroll 1
    for (int item = c0; item < NTOK / 16; item += cs) {
        const int tok0 = item * 16, ts0 = tok0 & (SEQ - 1);
        unsigned win[46];
#pragma unroll
        for (int r = 0; r < 46; ++r) { const int tt = ts0 - 30 + r; win[r] = 0u; if (tt >= 0) win[r] = *(const unsigned*)((const char*)HC + ((unsigned)(tok0 - 30 + r) * CONVW + c2) * 2u); }
        f32x2 xw[46];
#pragma unroll
        for (int r = 0; r < 46; ++r) xw[r] = (f32x2){bflo(win[r]), bfhi(win[r])};
        f32x2 av[16];
#pragma unroll
        for (int i = 0; i < 16; ++i) av[i] = bdw;
#pragma unroll
        for (int j = 0; j < CONV_K; ++j) {
#pragma unroll
            for (int i = 0; i < 16; ++i) av[i] = __builtin_elementwise_fma(wt[j], xw[i + j], av[i]); }
        float a0[16], a1[16];
#pragma unroll
        for (int i = 0; i < 16; ++i) { a0[i] = av[i].x; a1[i] = av[i].y; }
#pragma unroll
        for (int i = 0; i < 16; ++i) { P[(2 * i) * 512 + tid] = a0[i] + a1[i]; P[(2 * i + 1) * 512 + tid] = a0[i] * a0[i] + a1[i] * a1[i]; }
        LDS_WAIT(); __syncthreads();
        { const int v = tid >> 4, sub = tid & 15; float sacc = 0.f;
#pragma unroll 8
          for (int q = 0; q < 32; ++q) sacc += P[v * 512 + sub + 16 * q];
          sacc += swz_xor<8>(sacc); sacc += swz_xor<4>(sacc); sacc += swz_xor<2>(sacc); sacc += swz_xor<1>(sacc);
          if (sub == 0) ST[v] = sacc; }
        LDS_WAIT(); __syncthreads();
#pragma unroll
        for (int i = 0; i < 16; ++i) { const float mean = ST[2 * i] * (1.f / CONVW); const float var = ST[2 * i + 1] * (1.f / CONVW) - mean * mean; const float rstd = rsqrtf(fmaxf(var, 0.f) + LN_EPS);
            const float o0 = silu_f((a0[i] - mean) * rstd * gg.x + bb.x), o1 = silu_f((a1[i] - mean) * rstd * gg.y + bb.y);
            *(unsigned*)((char*)MIX + ((unsigned)(tok0 + i) * D_MODEL + SSMW + c2) * 2u) = pk2(o0, o1); }
        __syncthreads();
    }
}

__device__ __forceinline__ void ln_row(float (&x)[4][8], const float* g, const float* b, int lane) {
    float s = 0.f;
#pragma unroll
    for (int j = 0; j < 4; ++j)
#pragma unroll
        for (int i = 0; i < 8; ++i) s += x[j][i];
    const float mean = wave_sum(s) * (1.f / D_MODEL); float q = 0.f;
#pragma unroll
    for (int j = 0; j < 4; ++j)
#pragma unroll
        for (int i = 0; i < 8; ++i) { x[j][i] -= mean; q += x[j][i] * x[j][i]; }
    const float rstd = rsqrtf(wave_sum(q) * (1.f / D_MODEL) + LN_EPS);
#pragma unroll
    for (int j = 0; j < 4; ++j) { const f32x4 g0 = *(const f32x4*)(g + 8 * lane + 512 * j), g1 = *(const f32x4*)(g + 8 * lane + 512 * j + 4), b0 = *(const f32x4*)(b + 8 * lane + 512 * j), b1 = *(const f32x4*)(b + 8 * lane + 512 * j + 4);
#pragma unroll
        for (int i = 0; i < 4; ++i) { x[j][i] = x[j][i] * rstd * g0[i] + b0[i]; x[j][4 + i] = x[j][4 + i] * rstd * g1[i] + b1[i]; } }
}
__device__ __forceinline__ void load_row_f32(const float* p, float (&x)[4][8], int lane) {
#pragma unroll
    for (int j = 0; j < 4; ++j) { const f32x4 a = *(const f32x4*)(p + 8 * lane + 512 * j), b = *(const f32x4*)(p + 8 * lane + 512 * j + 4);
#pragma unroll
        for (int i = 0; i < 4; ++i) { x[j][i] = a[i]; x[j][4 + i] = b[i]; } }
}

constexpr int HR_PITCH = 4112;
__device__ __forceinline__ void p_ln1_router(Frame& F, int l) {
    const int lane = F.lane, w = F.wave, tid = F.tid;
    LAS unsigned char* Hrow = F.lds;
    LAS float* Part = (LAS float*)(F.lds + 65792);
    LAS float* Lg = (LAS float*)(F.lds + 65792 + 24576);
    bf16* H1 = wsb(F, WS_H1);
    const float* V = (const float*)wsp(F, WS_V);
    const int fr = lane & 15, kq = lane >> 4;
    v4u Bw[8][3];
    { const bf16* Wr = wlayer(F, l, WO_R);
#pragma unroll
      for (int ks = 0; ks < 8; ++ks)
#pragma unroll
          for (int nt = 0; nt < 3; ++nt) Bw[ks][nt] = *(const v4u*)((const char*)Wr + ((unsigned)(16 * nt + fr) * D_MODEL + 256 * w + 32 * ks + 8 * kq) * 2u); }
    const float* lng = inp(F, I_LN1G) + (size_t)l * D_MODEL; const float* lnb = inp(F, I_LN1B) + (size_t)l * D_MODEL;
#pragma unroll 1
    for (int item = F.blk; item < NTOK / 16; item += F.G) {
        float x0[4][8], x1[4][8];
        const unsigned row0 = (unsigned)item * 16 + 2 * w;
        load_row_f32(V + (size_t)row0 * D_MODEL, x0, lane); load_row_f32(V + (size_t)(row0 + 1) * D_MODEL, x1, lane);
        ln_row(x0, lng, lnb, lane); ln_row(x1, lng, lnb, lane);
#pragma unroll
        for (int j = 0; j < 4; ++j) { const v4u p0 = pack8(x0[j]), p1 = pack8(x1[j]);
            *(v4u*)((char*)H1 + ((row0) * D_MODEL + 8 * lane + 512 * j) * 2u) = p0; *(v4u*)((char*)H1 + ((row0 + 1) * D_MODEL + 8 * lane + 512 * j) * 2u) = p1;
            *(LAS v4u*)(Hrow + (2 * w) * HR_PITCH + (8 * lane + 512 * j) * 2) = p0; *(LAS v4u*)(Hrow + (2 * w + 1) * HR_PITCH + (8 * lane + 512 * j) * 2) = p1; }
        LDS_WAIT(); __syncthreads();
        { f32x4 acc[3]; acc[0] = acc[1] = acc[2] = (f32x4){0.f, 0.f, 0.f, 0.f};
#pragma unroll
          for (int ks = 0; ks < 8; ++ks) { const int kb = 256 * w + 32 * ks + 8 * kq;
              const bf16x8 Af = *(const LAS bf16x8*)(Hrow + fr * HR_PITCH + kb * 2);
#pragma unroll
              for (int nt = 0; nt < 3; ++nt) acc[nt] = __builtin_amdgcn_mfma_f32_16x16x32_bf16(Af, __builtin_bit_cast(bf16x8, Bw[ks][nt]), acc[nt], 0, 0, 0); }
#pragma unroll
          for (int nt = 0; nt < 3; ++nt)
#pragma unroll
              for (int r = 0; r < 4; ++r) Part[(w * 16 + 4 * kq + r) * 48 + 16 * nt + fr] = acc[nt][r]; }
        LDS_WAIT(); __syncthreads();
        for (int o = tid; o < 16 * 48; o += NWAVES * 64) { float sacc = 0.f;
#pragma unroll
            for (int ww = 0; ww < 8; ++ww) sacc += Part[ww * 768 + o];
            const int n = o % 48; if (n < NEG) sacc += inp(F, I_BRG)[l * NEG + n]; else if (n < NEG + NEXP) sacc += inp(F, I_BRE2)[l * NEXP + n - NEG];
            Lg[o] = sacc; }
        LDS_WAIT(); __syncthreads();
        if (tid < 16) { const LAS float* lg = Lg + tid * 48; const int tokn = item * 16 + tid;
            int gi = 0; float gm = lg[0];
#pragma unroll
            for (int i = 1; i < NEG; ++i) if (lg[i] > gm) { gm = lg[i]; gi = i; }
            float gs = 0.f;
#pragma unroll
            for (int i = 0; i < NEG; ++i) gs += __expf(lg[i] - gm);
            const float gp = 1.f / gs;
            const LAS float* el = lg + NEG + EPG * gi;
            int i0 = 0; float v0 = el[0];
#pragma unroll
            for (int i = 1; i < EPG; ++i) if (el[i] > v0) { v0 = el[i]; i0 = i; }
            int i1 = -1; float v1 = -3.0e38f;
#pragma unroll
            for (int i = 0; i < EPG; ++i) if (i != i0 && el[i] > v1) { v1 = el[i]; i1 = i; }
            const float ex = __expf(v1 - v0), w0 = gp / (1.f + ex), w1 = gp * ex / (1.f + ex);
            const int e0 = gi * EPG + i0, e1 = gi * EPG + i1;
            unsigned* cnt = ctlw(F) + CW_CNT + l * NEXP * 16;
            const unsigned p0 = atomicAdd(cnt + e0 * 16, 1u), p1 = atomicAdd(cnt + e1 * 16, 1u);
            int* tk = (int*)wsp(F, WS_TOK); float* tw = (float*)wsp(F, WS_TOK + 256 * 1024);
            tk[tokn * 4 + 0] = e0; tk[tokn * 4 + 1] = e1; tk[tokn * 4 + 2] = (int)p0; tk[tokn * 4 + 3] = (int)p1; tw[tokn * 2 + 0] = w0; tw[tokn * 2 + 1] = w1; }
        __syncthreads();
    }
}

__device__ __forceinline__ void p_gather(Frame& F, int l) {
    LAS int* off = (LAS int*)F.lds;
    const unsigned* cnt = ctlw(F) + CW_CNT + l * NEXP * 16;
    if (F.tid == 0) { int tb = 0; int* te = (int*)(ctlw(F) + CW_TE + l * 128);
#pragma unroll 1
        for (int e = 0; e < NEXP; ++e) { const int c = (int)cnt[e * 16], nt = (c + 255) >> 8; off[e] = tb * 256;
            if (F.blk == 0) {
#pragma unroll 1
                for (int t = 0; t < nt; ++t) te[tb + t] = e; }
            tb += nt; }
        if (F.blk == 0) *(int*)(ctlw(F) + CW_NT + 64 * l) = tb; }
    LDS_WAIT(); __syncthreads();
    const int* tk = (const int*)(wsp(F, WS_TOK)); const float* tw = (const float*)(wsp(F, WS_TOK + 256 * 1024));
    int* tslot = (int*)(wsp(F, WS_TOK + 512 * 1024)); float* roww = (float*)(wsp(F, WS_ROWW));
    const bf16* H1 = wsb(F, WS_H1); bf16* XS = wsb(F, WS_XS);
    for (int pr = F.blk * NWAVES + F.wave; pr < NTOK * 2; pr += F.G * NWAVES) { const int t = pr >> 1, k = pr & 1;
        const int e = tk[t * 4 + k], pos = tk[t * 4 + 2 + k]; const int slot = off[e] + pos;
        const v4u* s = (const v4u*)(H1 + (size_t)t * D_MODEL); v4u* d = (v4u*)(XS + (size_t)slot * D_MODEL);
#pragma unroll
        for (int j = 0; j < 4; ++j) d[F.lane + 64 * j] = s[F.lane + 64 * j];
        if (F.lane == 0) { roww[slot] = tw[t * 2 + k]; tslot[pr] = slot; } }
    __syncthreads();
}

__device__ __forceinline__ void p_ln2(Frame& F, int l) {
    const bf16* H1 = wsb(F, WS_H1); const bf16* OS = wsb(F, WS_XS); bf16* H2 = wsb(F, WS_H2);
    const int* tslot = (const int*)(wsp(F, WS_TOK + 512 * 1024));
    for (int row = F.blk * NWAVES + F.wave; row < NTOK; row += F.G * NWAVES) { const int s0 = tslot[2 * row], s1 = tslot[2 * row + 1];
        float x[4][8];
#pragma unroll
        for (int j = 0; j < 4; ++j) { float a[8], b[8], c[8]; unpack8(*(const v4u*)(H1 + (size_t)row * D_MODEL + 8 * F.lane + 512 * j), a);
            unpack8(*(const v4u*)(OS + (size_t)s0 * D_MODEL + 8 * F.lane + 512 * j), b); unpack8(*(const v4u*)(OS + (size_t)s1 * D_MODEL + 8 * F.lane + 512 * j), c);
#pragma unroll
            for (int i = 0; i < 8; ++i) x[j][i] = ALPHA * a[i] + (b[i] + c[i]); }
        ln_row(x, inp(F, I_LN2G) + (size_t)l * D_MODEL, inp(F, I_LN2B) + (size_t)l * D_MODEL, F.lane);
#pragma unroll
        for (int j = 0; j < 4; ++j) *(v4u*)(H2 + (size_t)row * D_MODEL + 8 * F.lane + 512 * j) = pack8(x[j]); }
}
__device__ __forceinline__ void p_ln3(Frame& F, int l) {
    const float* V = (const float*)(wsp(F, WS_V)); bf16* XB = wsb(F, WS_XB);
    for (int row = F.blk * NWAVES + F.wave; row < NTOK; row += F.G * NWAVES) {
        float x[4][8]; load_row_f32(V + (size_t)row * D_MODEL, x, F.lane);
        ln_row(x, inp(F, I_LN3G) + (size_t)l * D_MODEL, inp(F, I_LN3B) + (size_t)l * D_MODEL, F.lane);
        if (l == DEPTH - 1) {
#pragma unroll
            for (int j = 0; j < 4; ++j) { *(f32x4*)(F.out + (size_t)row * D_MODEL + 8 * F.lane + 512 * j) = (f32x4){x[j][0], x[j][1], x[j][2], x[j][3]}; *(f32x4*)(F.out + (size_t)row * D_MODEL + 8 * F.lane + 512 * j + 4) = (f32x4){x[j][4], x[j][5], x[j][6], x[j][7]}; }
        } else {
#pragma unroll
            for (int j = 0; j < 4; ++j) *(v4u*)(XB + (size_t)row * D_MODEL + 8 * F.lane + 512 * j) = pack8(x[j]);
        }
    }
}

__global__ void __launch_bounds__(NWAVES * 64, 2) mk_fwd(Args args) {
    extern __shared__ __attribute__((aligned(16))) unsigned char lds[];
    Frame F;
    F.lds = (LAS unsigned char*)lds;
    F.tid = threadIdx.x; F.lane = F.tid & 63; F.wave = __builtin_amdgcn_readfirstlane(F.tid >> 6);
    const int wave0 = F.wave;
    F.blk = blockIdx.x; F.G = gridDim.x; F.z = 0; F.in = args.in; F.out = args.out; F.ws = args.ws;
    volatile LAS unsigned* MISC = (volatile LAS unsigned*)(F.lds + MISC_OFF);
    if (F.tid < 64) MISC[F.tid] = 0u;
    __syncthreads();
    const int lo = args.ph_lo, hi = args.ph_hi;
    XcdBarrier bar; bar.bar = (unsigned*)(args.ws + WS_CTL) + CW_BAR; bar.x = 0; bar.st = nullptr;
    if (hi - lo > 1) bar = xcd_barrier_post((unsigned*)(args.ws + WS_CTL) + CW_BAR, MISC + 8);
#define IN(k) (lo <= (k) && (k) < hi)
#define FRESH() do { int z_ = 0, g_ = gridDim.x, b_ = blockIdx.x, w_ = wave0; asm volatile("" : "+s"(z_), "+s"(g_), "+s"(b_), "+s"(w_)); \
    int l_ = (int)__builtin_amdgcn_mbcnt_hi(~0u, __builtin_amdgcn_mbcnt_lo(~0u, (unsigned)z_));   \
    F.z = z_; F.G = g_; F.blk = b_; F.wave = w_; F.lane = l_; F.tid = w_ * 64 + l_; } while (0)
#define SEAM(k) do { if (IN(k) && IN((k) + 1)) { int z_ = 0; asm volatile("" : "+s"(z_)); XcdBarrier bb_ = bar; bb_.bar = bar.bar + z_; bb_.x = bar.x + (unsigned)z_; xcd_barrier(bb_); } } while (0)
    LAS unsigned char* ring = F.lds;

    if (IN(0)) { FRESH(); p_prologue(F); SEAM(0); }

#pragma unroll 1
    for (int l = 0; l < DEPTH; ++l) {
        const int pb = 1 + PH_PER_LAYER * l;
        if (IN(pb + 0)) { FRESH();
            { pg8::Gemm g{wsb(F, WS_XB), wlayer(F, l, WO_IN), NTOK, INW, D_MODEL}; pg8::StaticOrder S; S.init(NTOK, INW, F.G, F.blk);
              EpiIn E{wsb(F, WS_U), wsb(F, WS_HC), inp(F, I_BIN) + (size_t)l * INW};
              pg8::gemm_phase<EpiIn, pg8::StaticOrder, true, true>(ring, g, S, E, F.tid); }
            { const int nfull = (NTOK / 256) * (INW / 256) - F.G;
              const bool spare = nfull > 0 && nfull < F.G;
              pg8::Gemm g{wsb(F, WS_PB) + (size_t)l * NTOK * PLE, wlayer(F, l, WO_P), NTOK, D_MODEL, PLE}; pg8::StaticOrder S;
              S.init(NTOK, D_MODEL, spare ? F.G - nfull : F.G, spare ? (F.blk >= nfull ? F.blk - nfull : (1 << 28)) : F.blk);
              EpiPlain E{wsb(F, WS_E1), D_MODEL};
              pg8::gemm_phase<EpiPlain, pg8::StaticOrder, true, true>(ring, g, S, E, F.tid); }
            SEAM(pb + 0);
        }
        if (IN(pb + 1)) { FRESH();
            for (int it = F.blk; it < BATCH * NGRP; it += F.G) scan_item(F, l, it);
            SEAM(pb + 1);
        }
        if (IN(pb + 2)) { FRESH();
            const bool split = F.G > 128;
            if (!split || F.blk < 128) {
                pg8::Gemm g{wsb(F, WS_Z), wlayer(F, l, WO_GLU), NTOK, SSMW, SSMW}; pg8::StaticOrder S; S.init(NTOK, SSMW, split ? 128 : F.G, F.blk);
                EpiGlu E{wsb(F, WS_Z), wsb(F, WS_MIX), inp(F, I_BGLU) + (size_t)l * SSMW};
                pg8::gemm_phase<EpiGlu, pg8::StaticOrder, true, true>(ring, g, S, E, F.tid); }
            if (!split || F.blk >= 128) {
                const int c0 = split ? F.blk - 128 : F.blk, cs = split ? F.G - 128 : F.G;
                p_conv(F, l, c0, cs); }
            SEAM(pb + 2);
        }
        if (IN(pb + 3)) { FRESH();
            pg8::Gemm g{wsb(F, WS_MIX), wlayer(F, l, WO_O), NTOK, D_MODEL, D_MODEL}; pg8::StaticOrder S; S.init(NTOK, D_MODEL, F.G, F.blk);
            EpiOut E{wsb(F, WS_XB), (float*)(wsp(F, WS_V)), inp(F, I_BO) + (size_t)l * D_MODEL};
            pg8::gemm_phase<EpiOut, pg8::StaticOrder, true, true>(ring, g, S, E, F.tid);
            SEAM(pb + 3);
        }
        if (IN(pb + 4)) { FRESH();
            p_ln1_router(F, l);
            SEAM(pb + 4);
        }
        if (IN(pb + 5)) { FRESH(); p_gather(F, l); SEAM(pb + 5); }
        if (IN(pb + 6)) { FRESH();
            const int ntl = *(const int*)(ctlw(F) + CW_NT + 64 * l);
            pg8::Gemm g{wsb(F, WS_XS), wlayer(F, l, WO_GU), SROWS, NEXP * 512, D_MODEL};
            pg8::MoeOrder S{(const int*)(ctlw(F) + CW_TE + l * 128), ntl, 2, F.G, F.blk};
            EpiMoeUp E{wsb(F, WS_HS), (const float*)wsp(F, WS_ROWW)};
            pg8::gemm_phase<EpiMoeUp, pg8::MoeOrder, true, true>(ring, g, S, E, F.tid);
            SEAM(pb + 6);
        }
        if (IN(pb + 7)) { FRESH();
            const int ntl = *(const int*)(ctlw(F) + CW_NT + 64 * l);
            pg8::Gemm g{wsb(F, WS_HS), wlayer(F, l, WO_D), SROWS, NEXP * D_MODEL, EH};
            pg8::MoeOrder S{(const int*)(ctlw(F) + CW_TE + l * 128), ntl, 8, F.G, F.blk};
            EpiPlain E{wsb(F, WS_XS), D_MODEL};
            pg8::gemm_phase<EpiPlain, pg8::MoeOrder, true, true>(ring, g, S, E, F.tid);
            SEAM(pb + 7);
        }
        if (IN(pb + 8)) { FRESH(); p_ln2(F, l); SEAM(pb + 8); }
        if (IN(pb + 9)) { FRESH();
            pg8::Gemm g{wsb(F, WS_H2), wlayer(F, l, WO_PG), NTOK, D_MODEL, D_MODEL}; pg8::StaticOrder S; S.init(NTOK, D_MODEL, F.G, F.blk);
            EpiGate E{wsb(F, WS_H2), wsb(F, WS_E1), (float*)(wsp(F, WS_V)), inp(F, I_BPG) + (size_t)l * D_MODEL};
            pg8::gemm_phase<EpiGate, pg8::StaticOrder, true, true>(ring, g, S, E, F.tid);
            SEAM(pb + 9);
        }
        if (IN(pb + 10)) { FRESH(); p_ln3(F, l); SEAM(pb + 10); }
    }
#undef IN
#undef SEAM
}

extern "C" void kernel_launch(void* const* d_in, const int* in_sizes, int n_in, void* d_out, int out_size, void* d_ws, size_t ws_size, hipStream_t stream) {
    static int grid = 0;
    if (grid == 0) {
        if (n_in != 36 || in_sizes[0] != NTOK * D_MODEL || out_size != NTOK * D_MODEL || ws_size < WS_END) { fprintf(stderr, "kernel_launch: unexpected shapes (n_in %d, in0 %d, out %d, ws %zu < %zu)\n", n_in, n_in > 0 ? in_sizes[0] : -1, out_size, ws_size, (size_t)WS_END); grid = -1; return; }
        int dev = 0, cus = 0, per_cu = 0;
        if (hipGetDevice(&dev) != hipSuccess || hipDeviceGetAttribute(&cus, hipDeviceAttributeMultiprocessorCount, dev) != hipSuccess) { grid = -1; return; }
        if (hipFuncSetAttribute((const void*)mk_fwd, hipFuncAttributeMaxDynamicSharedMemorySize, LDS_BYTES) != hipSuccess) { fprintf(stderr, "kernel_launch: hipFuncSetAttribute failed\n"); grid = -1; return; }
        if (hipOccupancyMaxActiveBlocksPerMultiprocessor(&per_cu, (const void*)mk_fwd, NWAVES * 64, LDS_BYTES) != hipSuccess || per_cu < 1) fprintf(stderr, "kernel_launch: occupancy query reports %d\n", per_cu);
        (void)hipGetLastError();
        grid = cus;
    }
    if (grid < 0) return;
    if (hipMemsetAsync((char*)d_ws + WS_CTL, 0, CTL_ZERO_BYTES, stream) != hipSuccess) return;
    Args a{};
    for (int i = 0; i < 36; ++i) a.in[i] = (const float*)d_in[i];
    a.out = (float*)d_out; a.ws = (unsigned char*)d_ws;
#if MK_SINGLE
    a.ph_lo = 0; a.ph_hi = NPHASES;
    hipLaunchKernelGGL(mk_fwd, dim3(grid), dim3(NWAVES * 64), LDS_BYTES, stream, a);
#else
    for (int ph = 0; ph < NPHASES; ++ph) { a.ph_lo = ph; a.ph_hi = ph + 1;
        hipLaunchKernelGGL(mk_fwd, dim3(grid), dim3(NWAVES * 64), LDS_BYTES, stream, a);
        const int pil = ph == 0 ? 0 : 1 + (ph - 1) % PH_PER_LAYER;
        if (pil == PROBE_DUP) {
            if (pil == 5) hipMemsetAsync((char*)d_ws + WS_CTL + CW_CNT * 4, 0, DEPTH * NEXP * 16 * 4, stream);
            hipLaunchKernelGGL(mk_fwd, dim3(grid), dim3(NWAVES * 64), LDS_BYTES, stream, a); } }
#endif
}
```

```cpp
#include <hip/hip_runtime.h>
#include <cstdio>
#include <cstdint>

#ifndef MK_SINGLE
#define MK_SINGLE 1
#endif
#ifndef PROBE_DUP
#define PROBE_DUP -1
#endif

namespace pg8 {
#define PG8_LAS __attribute__((address_space(3)))
typedef unsigned short bf16_t;
typedef short bf16x8 __attribute__((ext_vector_type(8)));
typedef float f32x4 __attribute__((ext_vector_type(4)));
typedef unsigned u32x4 __attribute__((ext_vector_type(4)));
constexpr int BM = 256, BK = 64, HALF = 128, HTB = HALF * BK * 2, STAGE_BYTES = 8 * HTB, NXCD = 8, WGM = 8;

__host__ __device__ __forceinline__ int lds_byte(int r, int c) { const int st = (r >> 4) * 2 + (c >> 5), rr = r & 15, cc = c & 31, ob = rr * 64 + cc * 2; return st * 1024 + (ob ^ (((ob >> 9) & 1) << 5)); }
__host__ __device__ __forceinline__ void stage_rc(int b, int& R, int& C) { const int st = b / 1024, sb = b % 1024, swz = sb ^ (((sb >> 9) & 1) << 5); R = (st >> 1) * 16 + swz / 64; C = (st & 1) * 32 + (swz % 64) / 2; }
__host__ __device__ __forceinline__ int perm32(int rho) { const int n = rho >> 4, i = rho & 15; return 8 * (i >> 2) + 4 * n + (i & 3); }

struct Unit { int pm, pn, pc; };
struct Gemm { const bf16_t* A; const bf16_t* Bt; int M, N, K; };

struct StaticOrder {
    int nM, nN, nwg, G, c;
    __host__ __device__ void init(int M, int N, int G_, int c_) { nM = M / BM; nN = N / BM; nwg = nM * nN; G = G_; c = c_; }
    __host__ __device__ bool next(int i, Unit& u) const {
        const long L = (long)i * G + c; if (L >= nwg) return false;
        int wgid = (int)L; { const int q = nwg / NXCD, r = nwg % NXCD, xcd = wgid % NXCD, off = wgid / NXCD; wgid = (xcd < r ? xcd * (q + 1) : r * (q + 1) + (xcd - r) * q) + off; }
        const int nig = WGM * nN, gid = wgid / nig, fm = gid * WGM, gsz = (nM - fm) < WGM ? (nM - fm) : WGM;
        u.pm = fm + ((wgid % nig) % gsz); u.pn = (wgid % nig) / gsz; u.pc = u.pn; return true;
    }
    __device__ __forceinline__ void a_ready(const Unit&) const {}
    __device__ __forceinline__ void done(const Unit&) const {}
};
struct MoeOrder {
    const int* te; int ntiles, NJ, G, c;
    __device__ bool next(int i, Unit& u) const {
        const long L = (long)i * G + c; if (L >= (long)ntiles * NJ) return false;
        const int tile = (int)L / NJ, j = (int)L % NJ; const int e = te[tile];
        u.pm = tile; u.pn = e * NJ + j; u.pc = j; return true;
    }
    __device__ __forceinline__ void a_ready(const Unit&) const {}
    __device__ __forceinline__ void done(const Unit&) const {}
};

typedef float f32x2_t __attribute__((ext_vector_type(2)));
typedef __bf16 bf16x2_t __attribute__((ext_vector_type(2)));
__device__ __forceinline__ unsigned cvt_pk_bf16(float lo, float hi) { const f32x2_t v = {lo, hi}; return __builtin_bit_cast(unsigned, __builtin_convertvector(v, bf16x2_t)); }

template <class Epi, class Sched, bool ALIGN_EPI = false, bool SP2 = false>
__device__ __forceinline__ void gemm_phase(PG8_LAS unsigned char* lds, const Gemm g, const Sched& S, const Epi& E, int tid) {
    asm volatile("" : "+v"(tid));
    const int wid = __builtin_amdgcn_readfirstlane(tid >> 6), lane = tid & 63, wr = wid >> 2, wc = wid & 3, fr = lane & 15, fq = lane >> 4;
    const int K = g.K, nt = K / BK;
    unsigned voffA[2], voffB[2];
#pragma unroll
    for (int i = 0; i < 2; ++i) { int R, C; stage_rc(tid * 16 + i * 8192, R, C); const int Rb = Epi::PERM ? ((R & ~31) + perm32(R & 31)) : R;
        voffA[i] = (unsigned)(R * K + C) * 2u; voffB[i] = (unsigned)(Rb * K + C) * 2u; }
    const size_t kstep = (size_t)(BK * 2);
    const size_t hstep = (size_t)HALF * K * 2;
    const size_t tstep = 2 * hstep;
    const unsigned ldsw = (unsigned)wid * 1024u;
    const int aoff = lds_byte(wr * 64 + fr, fq * 8), boff = lds_byte(wc * 32 + fr, fq * 8);
#define PG8_SA(b, h) (((b) * 2 + (h)) * HTB)
#define PG8_SB(b, h) ((4 + (b) * 2 + (h)) * HTB)
#define PG8_STAGE(bufoff, gbase, voff) do { _Pragma("unroll") for (int _i = 0; _i < 2; ++_i) \
        __builtin_amdgcn_global_load_lds((const unsigned*)((const char*)(gbase) + (voff)[_i]), (PG8_LAS unsigned*)(lds + (bufoff) + ldsw + _i * 8192), 16, 0, 0); } while (0)
#define PG8_LDA(dst, b, h) do { _Pragma("unroll") for (int m = 0; m < 4; ++m) _Pragma("unroll") for (int k = 0; k < 2; ++k) dst[m][k] = *(const PG8_LAS bf16x8*)(lds + PG8_SA(b, h) + aoff + m * 2048 + k * 1024); } while (0)
#define PG8_LDB(dst, b, h) do { _Pragma("unroll") for (int n = 0; n < 2; ++n) _Pragma("unroll") for (int k = 0; k < 2; ++k) dst[n][k] = *(const PG8_LAS bf16x8*)(lds + PG8_SB(b, h) + boff + n * 2048 + k * 1024); } while (0)
#define PG8_MMA(ai, bj, At, Bt) do { __builtin_amdgcn_s_setprio(1); _Pragma("unroll") for (int m = 0; m < 4; ++m) _Pragma("unroll") for (int n = 0; n < 2; ++n) _Pragma("unroll") for (int k = 0; k < 2; ++k) \
        acc[ai][bj][m][n] = __builtin_amdgcn_mfma_f32_16x16x32_bf16(Bt[n][k], At[m][k], acc[ai][bj][m][n], 0, 0, 0); __builtin_amdgcn_s_setprio(0); } while (0)
#define PG8_WAIT_V(n) asm volatile("s_waitcnt vmcnt(" #n ")" ::: "memory")
#define PG8_WAIT_L(n) asm volatile("s_waitcnt lgkmcnt(" #n ")" ::: "memory")
#define PG8_BAR __builtin_amdgcn_s_barrier()
#define PG8_SCHED __builtin_amdgcn_sched_barrier(0)
    Unit cur, nxt; int ui = 0;
    if (!S.next(0, cur)) return;
    f32x4 acc[2][2][4][2];
#pragma unroll
    for (int a = 0; a < 2; ++a)
#pragma unroll
        for (int b = 0; b < 2; ++b)
#pragma unroll
            for (int m = 0; m < 4; ++m)
#pragma unroll
                for (int n = 0; n < 2; ++n) acc[a][b][m][n] = (f32x4){0.f, 0.f, 0.f, 0.f};
    bf16x8 At[4][2], B0[2][2], B1[2][2];
    const char* cA = (const char*)g.A + (size_t)cur.pm * tstep; const char* cB = (const char*)g.Bt + (size_t)cur.pn * tstep;
    S.a_ready(cur);
    if constexpr (SP2) {
        PG8_STAGE(PG8_SB(0, 0), cB, voffB); PG8_STAGE(PG8_SB(0, 1), cB + hstep, voffB); PG8_STAGE(PG8_SA(0, 0), cA, voffA); PG8_STAGE(PG8_SA(0, 1), cA + hstep, voffA);
        if (wr == 1) PG8_BAR;
        PG8_WAIT_V(2); PG8_BAR;
        PG8_STAGE(PG8_SB(1, 0), cB + kstep, voffB); PG8_STAGE(PG8_SA(1, 0), cA + kstep, voffA); PG8_STAGE(PG8_SB(1, 1), cB + hstep + kstep, voffB);
        PG8_WAIT_V(6); PG8_BAR;
    } else {
        PG8_STAGE(PG8_SB(0, 0), cB, voffB); PG8_STAGE(PG8_SA(0, 0), cA, voffA); PG8_STAGE(PG8_SB(0, 1), cB + hstep, voffB); PG8_STAGE(PG8_SA(0, 1), cA + hstep, voffA);
        if (wr == 1) PG8_BAR;
        PG8_WAIT_V(4); PG8_BAR;
        PG8_STAGE(PG8_SB(1, 0), cB + kstep, voffB); PG8_STAGE(PG8_SA(1, 0), cA + kstep, voffA); PG8_STAGE(PG8_SB(1, 1), cB + hstep + kstep, voffB);
        PG8_WAIT_V(6); PG8_BAR;
    }
    for (;;) {
        const bool has_next = S.next(ui + 1, nxt);
        const char* nA = has_next ? (const char*)g.A + (size_t)nxt.pm * tstep : cA; const char* nB = has_next ? (const char*)g.Bt + (size_t)nxt.pn * tstep : cB;
        for (int t = 0; t < nt; t += 2) {
            const bool last = (t == nt - 2);
            const char* a1 = cA + (size_t)(t + 1) * kstep;
            const char* a2 = last ? nA : cA + (size_t)(t + 2) * kstep; const char* b2 = last ? nB : cB + (size_t)(t + 2) * kstep;
            const char* a3 = a2 + kstep; const char* b3 = b2 + kstep;
            if (last && has_next) S.a_ready(nxt);
            if constexpr (SP2) {
            PG8_LDB(B0, 0, 0); PG8_LDB(B1, 0, 1); PG8_SCHED; PG8_LDA(At, 0, 0); PG8_STAGE(PG8_SA(1, 1), a1 + hstep, voffA);
            PG8_WAIT_V(8); PG8_WAIT_L(0); PG8_BAR; PG8_MMA(0, 0, At, B0); PG8_MMA(0, 1, At, B1); PG8_BAR; PG8_SCHED;
            PG8_LDA(At, 0, 1); PG8_STAGE(PG8_SB(0, 0), b2, voffB); PG8_STAGE(PG8_SB(0, 1), b2 + hstep, voffB); PG8_STAGE(PG8_SA(0, 0), a2, voffA);
            PG8_WAIT_V(8); PG8_WAIT_L(0); PG8_BAR; PG8_MMA(1, 0, At, B0); PG8_MMA(1, 1, At, B1); PG8_BAR; PG8_SCHED;
            PG8_LDB(B0, 1, 0); PG8_LDB(B1, 1, 1); PG8_SCHED; PG8_LDA(At, 1, 0); PG8_STAGE(PG8_SA(0, 1), a2 + hstep, voffA);
            PG8_WAIT_V(8); PG8_WAIT_L(0); PG8_BAR; PG8_MMA(0, 0, At, B0); PG8_MMA(0, 1, At, B1); PG8_BAR; PG8_SCHED;
            PG8_LDA(At, 1, 1); PG8_STAGE(PG8_SB(1, 0), b3, voffB); PG8_STAGE(PG8_SB(1, 1), b3 + hstep, voffB); PG8_STAGE(PG8_SA(1, 0), a3, voffA);
            PG8_WAIT_V(8); PG8_WAIT_L(0); PG8_BAR; PG8_MMA(1, 0, At, B0); PG8_MMA(1, 1, At, B1); PG8_BAR; PG8_SCHED;
            } else {
            PG8_LDB(B0, 0, 0); PG8_SCHED; PG8_LDA(At, 0, 0); PG8_STAGE(PG8_SA(1, 1), a1 + hstep, voffA);
            PG8_WAIT_L(8); PG8_BAR; PG8_WAIT_L(0); PG8_MMA(0, 0, At, B0); PG8_BAR; PG8_SCHED;
            PG8_LDB(B1, 0, 1); PG8_STAGE(PG8_SB(0, 0), b2, voffB);
            PG8_BAR; PG8_WAIT_L(0); PG8_MMA(0, 1, At, B1); PG8_BAR;
            PG8_LDA(At, 0, 1); PG8_STAGE(PG8_SA(0, 0), a2, voffA);
            PG8_BAR; PG8_WAIT_L(0); PG8_MMA(1, 0, At, B0); PG8_BAR; PG8_SCHED;
            PG8_STAGE(PG8_SB(0, 1), b2 + hstep, voffB);
            PG8_WAIT_V(6); PG8_BAR; PG8_MMA(1, 1, At, B1); PG8_BAR;
            PG8_LDB(B0, 1, 0); PG8_SCHED; PG8_LDA(At, 1, 0); PG8_STAGE(PG8_SA(0, 1), a2 + hstep, voffA);
            PG8_WAIT_L(8); PG8_BAR; PG8_WAIT_L(0); PG8_MMA(0, 0, At, B0); PG8_BAR; PG8_SCHED;
            PG8_LDB(B1, 1, 1); PG8_STAGE(PG8_SB(1, 0), b3, voffB);
            PG8_BAR; PG8_WAIT_L(0); PG8_MMA(0, 1, At, B1); PG8_BAR;
            PG8_LDA(At, 1, 1); PG8_STAGE(PG8_SA(1, 0), a3, voffA);
            PG8_BAR; PG8_WAIT_L(0); PG8_MMA(1, 0, At, B0); PG8_BAR; PG8_SCHED;
            PG8_STAGE(PG8_SB(1, 1), b3 + hstep, voffB);
            PG8_WAIT_V(6); PG8_BAR; PG8_MMA(1, 1, At, B1); PG8_BAR;
            }
        }
        if constexpr (ALIGN_EPI) { if (wr == 0) PG8_BAR; }
        E(acc, cur, wr, wc, fr, fq); S.done(cur);
        if (!has_next) break;
#pragma unroll
        for (int a = 0; a < 2; ++a)
#pragma unroll
            for (int b = 0; b < 2; ++b)
#pragma unroll
                for (int m = 0; m < 4; ++m)
#pragma unroll
                    for (int n = 0; n < 2; ++n) acc[a][b][m][n] = (f32x4){0.f, 0.f, 0.f, 0.f};
        cur = nxt; cA = nA; cB = nB; ++ui;
        if constexpr (ALIGN_EPI) { if (wr == 1) PG8_BAR; }
    }
    PG8_WAIT_V(0);
    if constexpr (!ALIGN_EPI) { if (wr == 0) PG8_BAR; }
    PG8_BAR;
#undef PG8_SA
#undef PG8_SB
#undef PG8_STAGE
#undef PG8_LDA
#undef PG8_LDB
#undef PG8_MMA
#undef PG8_WAIT_V
#undef PG8_WAIT_L
#undef PG8_BAR
#undef PG8_SCHED
}
}

constexpr int NWAVES = 8;
constexpr int D_MODEL = 2048, BATCH = 4, SEQ = 2048, DEPTH = 4, NTOK = BATCH * SEQ;
constexpr int SSMW = 1024, CONVW = 1024, NGRP = 64, CH = 16, NST = 64, INW = 3072, CONV_K = 31;
constexpr int NEG = 4, EPG = 8, NEXP = 32, EH = 256, PLE = 256;
constexpr int SROWS = 24576;
constexpr int MAXTILES = SROWS / 256;
constexpr float ALPHA = 1.681792830507429f;
constexpr float LN_EPS = 1e-5f;

constexpr int PH_PER_LAYER = 11, NPHASES = 1 + PH_PER_LAYER * DEPTH;

constexpr size_t MiB = 1u << 20;
constexpr size_t WS_CTL = 0, CTL_ZERO_BYTES = 1 * MiB;
constexpr size_t WS_W0 = 1 * MiB, W_LAYER = 128 * MiB;
constexpr size_t WO_IN = 0, WO_GLU = 12 * MiB, WO_O = 14 * MiB, WO_GU = 22 * MiB, WO_D = 86 * MiB, WO_PG = 118 * MiB, WO_P = 126 * MiB, WO_R = 127 * MiB;
constexpr size_t WS_ACT = WS_W0 + DEPTH * W_LAYER;
constexpr size_t WS_XB = WS_ACT, WS_PB = WS_XB + 32 * MiB, WS_U = WS_PB + 16 * MiB, WS_HC = WS_U + 16 * MiB, WS_Z = WS_HC + 16 * MiB, WS_MIX = WS_Z + 16 * MiB,
                 WS_V = WS_MIX + 32 * MiB, WS_H1 = WS_V + 64 * MiB, WS_XS = WS_H1 + 32 * MiB, WS_HS = WS_XS + 96 * MiB, WS_H2 = WS_HS + 12 * MiB, WS_E1 = WS_H2 + 32 * MiB,
                 WS_ROWW = WS_E1 + 32 * MiB, WS_TOK = WS_ROWW + 1 * MiB, WS_SSM = WS_TOK + 1 * MiB  , WS_END = WS_SSM + 25 * MiB;
constexpr int CW_TMO = 0, CW_BAR = 4096, CW_CNT = 8192  , CW_DBG = 12288  , CW_NT = 16384  , CW_TE = 20480  ;

constexpr int RING_BYTES = 143360;
constexpr int MISC_OFF = RING_BYTES;
constexpr int LDS_BYTES = 147456;

#define GAS __attribute__((address_space(1)))
#define LAS __attribute__((address_space(3)))
typedef unsigned short bf16;
typedef unsigned v4u __attribute__((ext_vector_type(4)));
typedef unsigned v2u __attribute__((ext_vector_type(2)));
typedef float f32x4 __attribute__((ext_vector_type(4)));
typedef float f32x2 __attribute__((ext_vector_type(2)));
typedef short bf16x8 __attribute__((ext_vector_type(8)));
#define LDS_WAIT() asm volatile("s_waitcnt lgkmcnt(0)" ::: "memory")
#define VM_WAIT() asm volatile("s_waitcnt vmcnt(0)" ::: "memory")
__device__ __forceinline__ float bflo(unsigned w) { return __uint_as_float(w << 16); }
__device__ __forceinline__ float bfhi(unsigned w) { return __uint_as_float(w & 0xffff0000u); }
__device__ __forceinline__ float bf2f(bf16 b) { return __uint_as_float((unsigned)b << 16); }
__device__ __forceinline__ unsigned f2bf(float f) { unsigned u = __float_as_uint(f); return (u + 0x7fffu + ((u >> 16) & 1u)) >> 16; }
__device__ __forceinline__ unsigned pk2(float lo, float hi) { return pg8::cvt_pk_bf16(lo, hi); }
__device__ __forceinline__ float sigm(float x) { return __builtin_amdgcn_rcpf(1.f + __expf(-x)); }
__device__ __forceinline__ float silu_f(float x) { return x * sigm(x); }
__device__ __forceinline__ float gelu_tanh(float y) { const float x = 0.7978845608028654f * (y + 0.044715f * y * y * y); const float t = 1.f - 2.f * __builtin_amdgcn_rcpf(1.f + __expf(2.f * x)); return 0.5f * y * (1.f + t); }
__device__ __forceinline__ void unpack8(const v4u w, float (&f)[8]) { f[0] = bflo(w.x); f[1] = bfhi(w.x); f[2] = bflo(w.y); f[3] = bfhi(w.y); f[4] = bflo(w.z); f[5] = bfhi(w.z); f[6] = bflo(w.w); f[7] = bfhi(w.w); }
__device__ __forceinline__ v4u pack8(const float (&f)[8]) { v4u w; w.x = pk2(f[0], f[1]); w.y = pk2(f[2], f[3]); w.z = pk2(f[4], f[5]); w.w = pk2(f[6], f[7]); return w; }
template <int X> __device__ __forceinline__ float swz_xor(float v) { return __int_as_float(__builtin_amdgcn_ds_swizzle(__float_as_int(v), (X << 10) | 0x1f)); }
__device__ __forceinline__ float wave_sum(float v) {
    v += swz_xor<1>(v); v += swz_xor<2>(v); v += swz_xor<4>(v); v += swz_xor<8>(v); v += swz_xor<16>(v);
    return __int_as_float(__builtin_amdgcn_readlane(__float_as_int(v), 0)) + __int_as_float(__builtin_amdgcn_readlane(__float_as_int(v), 32));
}

#define XB_TMO      128
#define XB_XCNT(j)  (256  + 64 * (j))
#define XB_XSUB(j)  (1280 + 64 * (j))
#define XB_XGEN(j)  (2304 + 64 * (j))
#define XB_TOP      3328
#define XB_TOPGEN   3392
#define XCD_BAR_WORDS 3456
#define XB_SPIN_CAP (1u << 18)
__device__ __forceinline__ unsigned xb_ld(unsigned* p)              { return __hip_atomic_load(p, __ATOMIC_RELAXED, __HIP_MEMORY_SCOPE_AGENT); }
__device__ __forceinline__ unsigned xb_add(unsigned* p, unsigned v) { return __hip_atomic_fetch_add(p, v, __ATOMIC_RELAXED, __HIP_MEMORY_SCOPE_AGENT); }
__device__ __forceinline__ unsigned xb_xcc_id() { return (unsigned)__builtin_amdgcn_s_getreg((3 << 11) | 20) & 0xFu; }
#define XB_SPIN(cond, bar) do { unsigned _sp = 0; while (cond) { __builtin_amdgcn_s_sleep(1); \
    if ((++_sp & 255u) == 0u) { if (xb_ld(&(bar)[XB_TMO])) break; if (_sp > XB_SPIN_CAP) { atomicAdd(&(bar)[XB_TMO], 1u); break; } } } } while (0)
struct XcdBarrier { unsigned* bar; unsigned x; volatile LAS unsigned* st; };
__device__ __forceinline__ XcdBarrier xcd_barrier_post(unsigned* bar, volatile LAS unsigned* st) {
    XcdBarrier b; b.bar = bar; b.x = xb_xcc_id(); b.st = st;
    if (threadIdx.x == 0) (void)xb_add(&bar[XB_XCNT(b.x)], 1u);
    return b;
}
__device__ __forceinline__ void xcd_barrier_complete(unsigned* bar, unsigned x, unsigned& nloc, unsigned& nx) {
    const unsigned G = gridDim.x * gridDim.y * gridDim.z;
    unsigned sum, cnt, mine, sp = 0u;
    for (;;) {
        sum = 0u; cnt = 0u; mine = 0u;
#pragma unroll
        for (unsigned j = 0; j < 16; ++j) { const unsigned c = xb_ld(&bar[XB_XCNT(j)]); sum += c; cnt += (c > 0u) ? 1u : 0u; mine = (j == x) ? c : mine; }
        if (sum == G) break;
        __builtin_amdgcn_s_sleep(1);
        if ((++sp & 255u) == 0u) { if (xb_ld(&bar[XB_TMO])) break; if (sp > XB_SPIN_CAP) { atomicAdd(&bar[XB_TMO], 1u); break; } }
    }
    nloc = mine > 0u ? mine : 1u; nx = cnt > 0u ? cnt : 1u;
}
__device__ __forceinline__ void xcd_barrier(const XcdBarrier& b) {
    asm volatile("s_waitcnt vmcnt(0)" ::: "memory");
    __syncthreads();
    if (threadIdx.x == 0) {
        unsigned* bar = b.bar;
        __builtin_amdgcn_s_waitcnt(0);
        unsigned nloc = b.st[0], nx = b.st[1];
        if (nloc == 0u) { xcd_barrier_complete(bar, b.x, nloc, nx); b.st[0] = nloc; b.st[1] = nx; }
        const unsigned old = xb_add(&bar[XB_XSUB(b.x)], 1u);
        const unsigned gen = old / nloc;
        if (old + 1u == (gen + 1u) * nloc) {
            __builtin_amdgcn_fence(__ATOMIC_RELEASE, "agent");
            asm volatile("s_waitcnt vmcnt(0)" ::: "memory");
            const unsigned og = xb_add(&bar[XB_TOP], 1u);
            const unsigned tg = og / nx;
            if (og + 1u == (tg + 1u) * nx) xb_add(&bar[XB_TOPGEN], 1u);
            else XB_SPIN(xb_ld(&bar[XB_TOPGEN]) == tg, bar);
            __builtin_amdgcn_fence(__ATOMIC_ACQUIRE, "agent");
            xb_add(&bar[XB_XGEN(b.x)], 1u);
            asm volatile("s_waitcnt vmcnt(0)" ::: "memory");
        } else {
            XB_SPIN(xb_ld(&bar[XB_XGEN(b.x)]) == gen, bar);
            __builtin_amdgcn_fence(__ATOMIC_ACQUIRE, "agent");
            asm volatile("s_waitcnt vmcnt(0)" ::: "memory");
        }
    }
    __syncthreads();
}

struct Args { const float* in[36]; float* out; unsigned char* ws; int ph_lo, ph_hi; };
enum { I_X = 0, I_P, I_WIN, I_BIN, I_LAMRE, I_LAMIM, I_LOGDT, I_BRE, I_BIM, I_CRE, I_CIM, I_SSMD, I_WGLU, I_BGLU, I_WDW, I_BDW, I_CLNG, I_CLNB, I_WO, I_BO, I_LN1G, I_LN1B,
       I_WRG, I_BRG, I_WRE, I_BRE2, I_WGATE, I_WUP, I_WDOWN, I_LN2G, I_LN2B, I_WP, I_WPG, I_BPG, I_LN3G, I_LN3B };
struct Frame {
    LAS unsigned char* lds;
    int tid, lane, wave, blk, G;
    int z;
    const float* const* in; float* out; unsigned char* ws;
};
__device__ __forceinline__ const float* inp(const Frame& F, int i) { return F.in[i + F.z]; }
__device__ __forceinline__ unsigned char* wsp(const Frame& F, size_t off) { return F.ws + (off + (size_t)(unsigned)F.z); }
__device__ __forceinline__ bf16* wsb(const Frame& F, size_t off) { return (bf16*)wsp(F, off); }
__device__ __forceinline__ bf16* wlayer(const Frame& F, int l, size_t off) { return (bf16*)wsp(F, WS_W0 + (size_t)l * W_LAYER + off); }
__device__ __forceinline__ unsigned* ctlw(const Frame& F) { return (unsigned*)wsp(F, WS_CTL); }

using pg8::Unit; using pg8::HALF; using pg8::BM;
__device__ __forceinline__ v4u ld16(const void* base, unsigned boff) { return *(const v4u*)((const char*)base + boff); }
__device__ __forceinline__ void st16(void* base, unsigned boff, v4u v) { *(v4u*)((char*)base + boff) = v; }
__device__ __forceinline__ f32x4 ldf4(const void* base, unsigned boff) { return *(const f32x4*)((const char*)base + boff); }
__device__ __forceinline__ void stf4(void* base, unsigned boff, f32x4 v) { *(f32x4*)((char*)base + boff) = v; }
#define EPI_PIN() asm volatile("" : "+v"(fr), "+v"(fq))
struct EpiIn {
    static constexpr bool PERM = true;
    bf16* U; bf16* HC; const float* bias;
    __device__ __forceinline__ void operator()(const f32x4 (&acc)[2][2][4][2], const Unit& u, int wr, int wc, int fr, int fq) const {
        EPI_PIN();
        const unsigned row0 = u.pm * BM + wr * 64 + fr, cl = wc * 32 + 8 * fq;
        if (u.pn < 4) {
            f32x4 bv[2][2];
#pragma unroll
            for (int bj = 0; bj < 2; ++bj)
#pragma unroll
                for (int n = 0; n < 2; ++n) bv[bj][n] = ldf4(bias, (u.pn * BM + bj * HALF + cl + 4 * n) * 4u);
#pragma unroll
            for (int ai = 0; ai < 2; ++ai)
#pragma unroll
                for (int m = 0; m < 4; ++m) { const unsigned off = ((row0 + ai * HALF + m * 16) * SSMW + u.pn * BM + cl) * 2u;
#pragma unroll
                    for (int bj = 0; bj < 2; ++bj) { const f32x4 v0 = acc[ai][bj][m][0] + bv[bj][0], v1 = acc[ai][bj][m][1] + bv[bj][1];
                        v4u w; w.x = pk2(v0[0], v0[1]); w.y = pk2(v0[2], v0[3]); w.z = pk2(v1[0], v1[1]); w.w = pk2(v1[2], v1[3]);
                        st16(U, off + bj * HALF * 2u, w); } }
        } else {
            const unsigned chn = (u.pn - 4) * HALF + cl;
            f32x4 bvv[2], bgg[2];
#pragma unroll
            for (int n = 0; n < 2; ++n) { bvv[n] = ldf4(bias, (SSMW + chn + 4 * n) * 4u); bgg[n] = ldf4(bias, (SSMW + CONVW + chn + 4 * n) * 4u); }
#pragma unroll
            for (int ai = 0; ai < 2; ++ai)
#pragma unroll
                for (int m = 0; m < 4; ++m) { const unsigned off = ((row0 + ai * HALF + m * 16) * CONVW + chn) * 2u;
                    float o[8];
#pragma unroll
                    for (int n = 0; n < 2; ++n) { const f32x4 vv = acc[ai][0][m][n] + bvv[n], gg = acc[ai][1][m][n] + bgg[n];
#pragma unroll
                        for (int j = 0; j < 4; ++j) o[4 * n + j] = vv[j] * sigm(gg[j]); }
                    st16(HC, off, pack8(o)); }
        }
    }
};
struct EpiGlu {
    static constexpr bool PERM = true;
    const bf16* Z; bf16* MIX; const float* bias;
    __device__ __forceinline__ void operator()(const f32x4 (&acc)[2][2][4][2], const Unit& u, int wr, int wc, int fr, int fq) const {
        EPI_PIN();
        const unsigned row0 = u.pm * BM + wr * 64 + fr, col0 = u.pc * BM + wc * 32 + 8 * fq;
        f32x4 bv[2][2];
#pragma unroll
        for (int bj = 0; bj < 2; ++bj)
#pragma unroll
            for (int n = 0; n < 2; ++n) bv[bj][n] = ldf4(bias, (col0 + bj * HALF + 4 * n) * 4u);
#pragma unroll
        for (int ai = 0; ai < 2; ++ai)
#pragma unroll
            for (int m = 0; m < 4; ++m) { const unsigned row = row0 + ai * HALF + m * 16;
#pragma unroll
                for (int bj = 0; bj < 2; ++bj) { const unsigned col = col0 + bj * HALF;
                    float zf[8]; unpack8(ld16(Z, (row * SSMW + col) * 2u), zf);
                    const f32x4 v0 = acc[ai][bj][m][0] + bv[bj][0], v1 = acc[ai][bj][m][1] + bv[bj][1];
                    float o[8];
#pragma unroll
                    for (int j = 0; j < 4; ++j) { o[j] = zf[j] * sigm(v0[j]); o[4 + j] = zf[4 + j] * sigm(v1[j]); }
                    st16(MIX, (row * D_MODEL + col) * 2u, pack8(o)); }
                asm volatile("" ::: "memory"); }
    }
};
struct EpiPlain {
    static constexpr bool PERM = true;
    bf16* O; int ldc;
    __device__ __forceinline__ void operator()(const f32x4 (&acc)[2][2][4][2], const Unit& u, int wr, int wc, int fr, int fq) const {
        EPI_PIN();
        const unsigned row0 = u.pm * BM + wr * 64 + fr, col0 = u.pc * BM + wc * 32 + 8 * fq;
#pragma unroll
        for (int ai = 0; ai < 2; ++ai)
#pragma unroll
            for (int m = 0; m < 4; ++m) { const unsigned off = ((row0 + ai * HALF + m * 16) * (unsigned)ldc + col0) * 2u;
#pragma unroll
                for (int bj = 0; bj < 2; ++bj) { const f32x4 v0 = acc[ai][bj][m][0], v1 = acc[ai][bj][m][1];
                    v4u w; w.x = pk2(v0[0], v0[1]); w.y = pk2(v0[2], v0[3]); w.z = pk2(v1[0], v1[1]); w.w = pk2(v1[2], v1[3]);
                    st16(O, off + bj * HALF * 2u, w); } }
    }
};
struct EpiOut {
    static constexpr bool PERM = true;
    const bf16* XB; float* V; const float* bias;
    __device__ __forceinline__ void operator()(const f32x4 (&acc)[2][2][4][2], const Unit& u, int wr, int wc, int fr, int fq) const {
        EPI_PIN();
        const unsigned row0 = u.pm * BM + wr * 64 + fr, col0 = u.pc * BM + wc * 32 + 8 * fq;
        f32x4 bv[2][2];
#pragma unroll
        for (int bj = 0; bj < 2; ++bj)
#pragma unroll
            for (int n = 0; n < 2; ++n) bv[bj][n] = ldf4(bias, (col0 + bj * HALF + 4 * n) * 4u);
#pragma unroll
        for (int ai = 0; ai < 2; ++ai)
#pragma unroll
            for (int m = 0; m < 4; ++m) { const unsigned eoff = (row0 + ai * HALF + m * 16) * D_MODEL + col0;
#pragma unroll
                for (int bj = 0; bj < 2; ++bj) { float xf[8]; unpack8(ld16(XB, (eoff + bj * HALF) * 2u), xf);
                    f32x4 o0 = acc[ai][bj][m][0] + bv[bj][0], o1 = acc[ai][bj][m][1] + bv[bj][1];
#pragma unroll
                    for (int j = 0; j < 4; ++j) { o0[j] += ALPHA * xf[j]; o1[j] += ALPHA * xf[4 + j]; }
                    stf4(V, (eoff + bj * HALF) * 4u, o0); stf4(V, (eoff + bj * HALF + 4) * 4u, o1); }
                asm volatile("" ::: "memory"); }
    }
};
struct EpiMoeUp {
    static constexpr bool PERM = true;
    bf16* HS; const float* roww;
    __device__ __forceinline__ void operator()(const f32x4 (&acc)[2][2][4][2], const Unit& u, int wr, int wc, int fr, int fq) const {
        EPI_PIN();
        const unsigned row0 = u.pm * BM + wr * 64 + fr, cl = u.pc * HALF + wc * 32 + 8 * fq;
#pragma unroll
        for (int ai = 0; ai < 2; ++ai)
#pragma unroll
            for (int m = 0; m < 4; ++m) { const unsigned row = row0 + ai * HALF + m * 16; const float rw = *(const float*)((const char*)roww + row * 4u);
                float o[8];
#pragma unroll
                for (int n = 0; n < 2; ++n) { const f32x4 gg = acc[ai][0][m][n], uu = acc[ai][1][m][n];
#pragma unroll
                    for (int j = 0; j < 4; ++j) o[4 * n + j] = silu_f(gg[j]) * uu[j] * rw; }
                st16(HS, (row * EH + cl) * 2u, pack8(o)); }
    }
};
struct EpiGate {
    static constexpr bool PERM = true;
    const bf16* H2; const bf16* E1; float* V; const float* bias;
    __device__ __forceinline__ void operator()(const f32x4 (&acc)[2][2][4][2], const Unit& u, int wr, int wc, int fr, int fq) const {
        EPI_PIN();
        const unsigned row0 = u.pm * BM + wr * 64 + fr, col0 = u.pc * BM + wc * 32 + 8 * fq;
        f32x4 bv[2][2];
#pragma unroll
        for (int bj = 0; bj < 2; ++bj)
#pragma unroll
            for (int n = 0; n < 2; ++n) bv[bj][n] = ldf4(bias, (col0 + bj * HALF + 4 * n) * 4u);
#pragma unroll
        for (int ai = 0; ai < 2; ++ai)
#pragma unroll
            for (int m = 0; m < 4; ++m) { const unsigned eoff = (row0 + ai * HALF + m * 16) * D_MODEL + col0;
#pragma unroll
                for (int bj = 0; bj < 2; ++bj) { float hf[8], ef[8]; unpack8(ld16(H2, (eoff + bj * HALF) * 2u), hf); unpack8(ld16(E1, (eoff + bj * HALF) * 2u), ef);
                    const f32x4 a0 = acc[ai][bj][m][0] + bv[bj][0], a1 = acc[ai][bj][m][1] + bv[bj][1]; f32x4 o0, o1;
#pragma unroll
                    for (int j = 0; j < 4; ++j) { o0[j] = ALPHA * hf[j] + ef[j] * sigm(a0[j]); o1[j] = ALPHA * hf[4 + j] + ef[4 + j] * sigm(a1[j]); }
                    stf4(V, (eoff + bj * HALF) * 4u, o0); stf4(V, (eoff + bj * HALF + 4) * 4u, o1); }
                asm volatile("" ::: "memory"); }
    }
};

__device__ __forceinline__ void transpose_tile(const float* src, int ldn, int k0, int n0, bf16* dst, size_t drow0, int ldk, LAS float* scr, int lane) {
    const int lr = lane >> 4, lc = (lane & 15) * 4;
#pragma unroll 4
    for (int i = 0; i < 16; ++i) { const int kk = 4 * i + lr; const f32x4 v = *(const f32x4*)(src + (size_t)(k0 + kk) * ldn + n0 + lc);
        LAS float* s = scr + kk * 65 + lc; s[0] = v[0]; s[1] = v[1]; s[2] = v[2]; s[3] = v[3]; }
    LDS_WAIT(); asm volatile("" ::: "memory");
    const int kc = lane & 7;
#pragma unroll 2
    for (int j = 0; j < 8; ++j) { const int n = (lane >> 3) + 8 * j; const LAS float* s = scr + (8 * kc) * 65 + n;
        v4u o; o.x = pk2(s[0], s[65]); o.y = pk2(s[2 * 65], s[3 * 65]); o.z = pk2(s[4 * 65], s[5 * 65]); o.w = pk2(s[6 * 65], s[7 * 65]);
        *(v4u*)(dst + (drow0 + n) * (size_t)ldk + k0 + 8 * kc) = o; }
    LDS_WAIT(); asm volatile("" ::: "memory");
}
__device__ __forceinline__ void ssm_tables_item(Frame& F, int lg);
__device__ __forceinline__ void p_prologue(Frame& F) {
    LAS float* scr = (LAS float*)(F.lds + F.wave * 16640);
    const int gw = F.blk * NWAVES + F.wave, NGW = F.G * NWAVES;
    constexpr int T_IN = 32 * 48, T_GLU = 16 * 16, T_O = 32 * 32, T_G = 32 * 128, T_D = 32 * 128, T_PG = 32 * 32, T_P = 4 * 32;
    constexpr int T_LAYER = T_IN + T_GLU + T_O + 2 * T_G + T_D + T_PG + T_P;
    for (int it = gw; it < T_LAYER * DEPTH; it += NGW) {
        const int l = it / T_LAYER; int r = it % T_LAYER;
        if (r < T_IN) { const int kt = r / 48, ntl = r % 48, n0 = 64 * ntl; int dr;
            if (n0 < SSMW) dr = n0; else { const int q = n0 - SSMW, part = q / CONVW, cc = q % CONVW; dr = SSMW + (cc / 128) * 256 + part * 128 + (cc % 128); }
            transpose_tile(inp(F, I_WIN) + (size_t)l * D_MODEL * INW, INW, 64 * kt, n0, wlayer(F, l, WO_IN), dr, D_MODEL, scr, F.lane); continue; } r -= T_IN;
        if (r < T_GLU) { const int kt = r / 16, ntl = r % 16;
            transpose_tile(inp(F, I_WGLU) + (size_t)l * SSMW * SSMW, SSMW, 64 * kt, 64 * ntl, wlayer(F, l, WO_GLU), 64 * ntl, SSMW, scr, F.lane); continue; } r -= T_GLU;
        if (r < T_O) { const int kt = r / 32, ntl = r % 32;
            transpose_tile(inp(F, I_WO) + (size_t)l * D_MODEL * D_MODEL, D_MODEL, 64 * kt, 64 * ntl, wlayer(F, l, WO_O), 64 * ntl, D_MODEL, scr, F.lane); continue; } r -= T_O;
        if (r < 2 * T_G) { const int up = r / T_G; const int rr = r % T_G; const int e = rr / 128, q = rr % 128, kt = q / 4, ntl = q % 4, n0 = 64 * ntl;
            const float* src = inp(F, up ? I_WUP : I_WGATE) + ((size_t)(l * NEXP + e) * D_MODEL) * EH;
            transpose_tile(src, EH, 64 * kt, n0, wlayer(F, l, WO_GU), (size_t)e * 512 + (n0 / 128) * 256 + up * 128 + (n0 % 128), D_MODEL, scr, F.lane); continue; } r -= 2 * T_G;
        if (r < T_D) { const int e = r / 128, q = r % 128, kt = q / 32, ntl = q % 32;
            const float* src = inp(F, I_WDOWN) + ((size_t)(l * NEXP + e) * EH) * D_MODEL;
            transpose_tile(src, D_MODEL, 64 * kt, 64 * ntl, wlayer(F, l, WO_D), (size_t)e * D_MODEL + 64 * ntl, EH, scr, F.lane); continue; } r -= T_D;
        if (r < T_PG) { const int kt = r / 32, ntl = r % 32;
            transpose_tile(inp(F, I_WPG) + (size_t)l * D_MODEL * D_MODEL, D_MODEL, 64 * kt, 64 * ntl, wlayer(F, l, WO_PG), 64 * ntl, D_MODEL, scr, F.lane); continue; } r -= T_PG;
        { const int kt = r / 32, ntl = r % 32;
            transpose_tile(inp(F, I_WP) + (size_t)l * PLE * D_MODEL, D_MODEL, 64 * kt, 64 * ntl, wlayer(F, l, WO_P), 64 * ntl, PLE, scr, F.lane); }
    }
    const int gt = F.blk * (NWAVES * 64) + F.tid, NGT = F.G * NWAVES * 64;
    for (int i = gt; i < DEPTH * 48 * D_MODEL; i += NGT) { const int l = i / (48 * D_MODEL), q = i % (48 * D_MODEL), n = q / D_MODEL, k = q % D_MODEL;
        float v = 0.f; if (n < NEG) v = inp(F, I_WRG)[((size_t)l * D_MODEL + k) * NEG + n]; else if (n < NEG + NEXP) v = inp(F, I_WRE)[((size_t)l * D_MODEL + k) * NEXP + (n - NEG)];
        wlayer(F, l, WO_R)[(size_t)n * D_MODEL + k] = (bf16)f2bf(v); }
    { const f32x4* xs = (const f32x4*)inp(F, I_X); v4u* xd = (v4u*)wsb(F, WS_XB);
      for (int i = gt; i < NTOK * D_MODEL / 8; i += NGT) { const f32x4 a = xs[2 * i], b = xs[2 * i + 1]; v4u w; w.x = pk2(a[0], a[1]); w.y = pk2(a[2], a[3]); w.z = pk2(b[0], b[1]); w.w = pk2(b[2], b[3]); xd[i] = w; }
      const f32x4* ps = (const f32x4*)inp(F, I_P); v4u* pd = (v4u*)wsb(F, WS_PB);
      for (int i = gt; i < DEPTH * NTOK * PLE / 8; i += NGT) { const f32x4 a = ps[2 * i], b = ps[2 * i + 1]; v4u w; w.x = pk2(a[0], a[1]); w.y = pk2(a[2], a[3]); w.z = pk2(b[0], b[1]); w.w = pk2(b[2], b[3]); pd[i] = w; } }
    __syncthreads();
    for (int it = F.blk; it < DEPTH * NGRP; it += F.G) ssm_tables_item(F, it);
}

constexpr int MAT_PITCH = 272, MAT_BYTES = 128 * MAT_PITCH;
constexpr int SSM_TAB_BYTES = 3 * 32768 + 1024;
__device__ __forceinline__ void ssm_lam(const Frame& F, int lg, int p, float& lre, float& lim, float& lbr, float& lbi) {
    const float dt = expf(inp(F, I_LOGDT)[lg]);
    lre = fminf(inp(F, I_LAMRE)[lg * NST + p], -1e-4f); lim = inp(F, I_LAMIM)[lg * NST + p];
    const float mag = expf(lre * dt); float sn, cs; sincosf(lim * dt, &sn, &cs);
    lbr = mag * cs; lbi = mag * sn;
}
__device__ __forceinline__ void ssm_tables_item(Frame& F, int lg) {
    const int tid = F.tid;
    LAS f32x2* pw = (LAS f32x2*)F.lds;
    LAS f32x2* Bb = (LAS f32x2*)(F.lds + 8192);
    LAS f32x2* Cc = (LAS f32x2*)(F.lds + 16384);
    LAS float* Kd = (LAS float*)(F.lds + 24576);
    LAS f32x2* cf = (LAS f32x2*)(F.lds + 32768);
    if (tid < 64) { float lre, lim, lbr, lbi; ssm_lam(F, lg, tid, lre, lim, lbr, lbi);
        const float nr = lbr - 1.f, ni = lbi, den = lre * lre + lim * lim; cf[tid] = (f32x2){(nr * lre + ni * lim) / den, (ni * lre - nr * lim) / den};
        float pr = 1.f, pi = 0.f;
        for (int k = 0; k < 9; ++k) { pw[k * 64 + tid] = (f32x2){pr, pi}; if (k < 8) { const float tr = pr * lbr - pi * lbi, ti = pr * lbi + pi * lbr; pr = tr; pi = ti; } }
        float qr = pr, qi = pi;
        for (int i = 0; i < 5; ++i) { const float tr = qr * qr - qi * qi, ti = 2.f * qr * qi; qr = tr; qi = ti; }
        *(f32x4*)(wsp(F, WS_SSM) + (size_t)lg * SSM_TAB_BYTES + 98304 + 16 * tid) = (f32x4){pr, pi, qr, qi}; }
    LDS_WAIT(); __syncthreads();
    for (int idx = tid; idx < 1024; idx += NWAVES * 64) { const int p = idx >> 4; const f32x2 c = cf[p];
        const float br = inp(F, I_BRE)[(size_t)lg * 1024 + idx], bi = inp(F, I_BIM)[(size_t)lg * 1024 + idx];
        Bb[idx] = (f32x2){c.x * br - c.y * bi, c.x * bi + c.y * br};
        Cc[idx] = (f32x2){inp(F, I_CRE)[(size_t)lg * 1024 + idx], inp(F, I_CIM)[(size_t)lg * 1024 + idx]}; }
    LDS_WAIT(); __syncthreads();
    for (int idx = tid; idx < 2048; idx += NWAVES * 64) { const int d = idx >> 8, h = (idx >> 4) & 15, h2 = idx & 15; float acc = 0.f;
        for (int p = 0; p < 64; ++p) { const f32x2 a = pw[d * 64 + p], bq = Bb[p * 16 + h2], c = Cc[h * 64 + p];
            const float zr = a.x * bq.x - a.y * bq.y, zi = a.x * bq.y + a.y * bq.x; acc += c.x * zr - c.y * zi; }
        if (d == 0 && h == h2) acc += inp(F, I_SSMD)[(size_t)(lg >> 6) * SSMW + (lg & 63) * CH + h];
        Kd[idx] = acc; }
    LDS_WAIT(); __syncthreads();
    unsigned* tabW = (unsigned*)(wsp(F, WS_SSM) + (size_t)lg * SSM_TAB_BYTES); unsigned* tabT = tabW + 8192; unsigned* tabG = tabW + 16384;
    for (int q = tid; q < 8192; q += NWAVES * 64) { const int row = q >> 6, k0 = (q & 63) * 2;
        { const int p = row & 63, t = k0 >> 4, h = k0 & 15; const f32x2 a = pw[(7 - t) * 64 + p], b0 = Bb[p * 16 + h], b1 = Bb[p * 16 + h + 1];
          const float v0 = (row < 64) ? (a.x * b0.x - a.y * b0.y) : (a.x * b0.y + a.y * b0.x), v1 = (row < 64) ? (a.x * b1.x - a.y * b1.y) : (a.x * b1.y + a.y * b1.x);
          tabW[q] = pk2(v0, v1); }
        { const int t = row >> 4, h = row & 15, sidx = k0 >> 4, h2 = k0 & 15; float v0 = 0.f, v1 = 0.f;
          if (sidx <= t) { v0 = Kd[(t - sidx) * 256 + h * 16 + h2]; v1 = Kd[(t - sidx) * 256 + h * 16 + h2 + 1]; }
          tabT[q] = pk2(v0, v1); }
        { const int t = row >> 4, h = row & 15, p = k0 >> 1; const f32x2 a = pw[(t + 1) * 64 + p], c = Cc[h * 64 + p];
          tabG[q] = pk2(c.x * a.x - c.y * a.y, -(c.x * a.y + c.y * a.x)); } }
    __syncthreads();
}
__device__ __forceinline__ void lds_load_table(LAS unsigned char* dst, const unsigned char* src, int tid) {
    v4u t[4];
#pragma unroll
    for (int i = 0; i < 4; ++i) t[i] = *(const v4u*)(src + (tid + 512 * i) * 16);
    asm volatile("" : "+v"(t[0]), "+v"(t[1]), "+v"(t[2]), "+v"(t[3]));
#pragma unroll
    for (int i = 0; i < 4; ++i) { const int ch = tid + 512 * i; *(LAS v4u*)(dst + (ch >> 4) * MAT_PITCH + (ch & 15) * 16) = t[i]; }
}
__device__ __forceinline__ void lds_load_table2(LAS unsigned char* dst0, LAS unsigned char* dst1, const unsigned char* src0, const unsigned char* src1, int tid) {
    v4u t[8];
#pragma unroll
    for (int i = 0; i < 4; ++i) { t[i] = *(const v4u*)(src0 + (tid + 512 * i) * 16); t[4 + i] = *(const v4u*)(src1 + (tid + 512 * i) * 16); }
    asm volatile("" : "+v"(t[0]), "+v"(t[1]), "+v"(t[2]), "+v"(t[3]), "+v"(t[4]), "+v"(t[5]), "+v"(t[6]), "+v"(t[7]));
#pragma unroll
    for (int i = 0; i < 4; ++i) { const int ch = tid + 512 * i; *(LAS v4u*)(dst0 + (ch >> 4) * MAT_PITCH + (ch & 15) * 16) = t[i]; *(LAS v4u*)(dst1 + (ch >> 4) * MAT_PITCH + (ch & 15) * 16) = t[4 + i]; }
}
__device__ __forceinline__ void scan_item(Frame& F, int l, int item) {
    const int b = item >> 6, g = item & 63, lane = F.lane, w = F.wave, tid = F.tid;
    const int fr = lane & 15, kq = lane >> 4;
    LAS unsigned char* R1 = F.lds; LAS unsigned char* R2 = F.lds + MAT_BYTES;
    LAS unsigned char* SB = F.lds + 2 * MAT_BYTES + w * 8704;
    LAS f32x2* Ebuf = (LAS f32x2*)(F.lds + 139264);
    const int lg = l * NGRP + g;
    const unsigned char* tab = wsp(F, WS_SSM) + (size_t)lg * SSM_TAB_BYTES;
    lds_load_table2(R1, R2, tab, tab + 32768, tid);
    const bf16* Ub = wsb(F, WS_U); bf16* Zb = wsb(F, WS_Z);
    const unsigned tokw = (unsigned)b * SEQ + 256 * w;
    v4u Uw[2][4];
#pragma unroll
    for (int nt = 0; nt < 2; ++nt)
#pragma unroll
        for (int kk = 0; kk < 4; ++kk) Uw[nt][kk] = *(const v4u*)((const char*)Ub + ((tokw + 8 * (16 * nt + fr) + 2 * kk + (kq >> 1)) * SSMW + g * CH + 8 * (kq & 1)) * 2u);
    const f32x4 apw = *(const f32x4*)(tab + 98304 + 16 * lane);
    const float a8r = apw[0], a8i = apw[1], a256r = apw[2], a256i = apw[3];
    LDS_WAIT(); __syncthreads();
    { f32x4 La[8][2];
#pragma unroll
      for (int mt = 0; mt < 8; ++mt) { La[mt][0] = (f32x4){0.f, 0.f, 0.f, 0.f}; La[mt][1] = (f32x4){0.f, 0.f, 0.f, 0.f}; }
#pragma unroll
      for (int mt = 0; mt < 8; ++mt)
#pragma unroll
          for (int kk = 0; kk < 4; ++kk) { const bf16x8 Af = *(const LAS bf16x8*)(R1 + (16 * mt + fr) * MAT_PITCH + (32 * kk + 8 * kq) * 2);
#pragma unroll
              for (int nt = 0; nt < 2; ++nt) La[mt][nt] = __builtin_amdgcn_mfma_f32_16x16x32_bf16(Af, __builtin_bit_cast(bf16x8, Uw[nt][kk]), La[mt][nt], 0, 0, 0); }
#pragma unroll
      for (int nt = 0; nt < 2; ++nt)
#pragma unroll
          for (int mt = 0; mt < 4; ++mt) { v4u pv; pv.x = pk2(La[mt][nt][0], La[mt + 4][nt][0]); pv.y = pk2(La[mt][nt][1], La[mt + 4][nt][1]); pv.z = pk2(La[mt][nt][2], La[mt + 4][nt][2]); pv.w = pk2(La[mt][nt][3], La[mt + 4][nt][3]);
              *(LAS v4u*)(SB + (16 * nt + fr) * MAT_PITCH + (16 * mt + 4 * kq) * 4) = pv; } }
    VM_WAIT(); LDS_WAIT(); __syncthreads();
    float ser[32], sei[32];
    { unsigned Lv[32];
#pragma unroll
      for (int j = 0; j < 32; ++j) Lv[j] = *(const LAS unsigned*)(SB + j * MAT_PITCH + 4 * lane);
      float sr = 0.f, si = 0.f;
#pragma unroll
      for (int j = 0; j < 32; ++j) { const float nr = fmaf(a8r, sr, fmaf(-a8i, si, bflo(Lv[j]))), ni = fmaf(a8r, si, fmaf(a8i, sr, bfhi(Lv[j]))); sr = nr; si = ni; ser[j] = sr; sei[j] = si; } }
    Ebuf[w * 64 + lane] = (f32x2){ser[31], sei[31]};
    LDS_WAIT(); __syncthreads();
    lds_load_table(R1, tab + 65536, tid);
    { float cr = 0.f, ci = 0.f;
      for (int i = 0; i < w; ++i) { const f32x2 e = Ebuf[i * 64 + lane]; const float nr = a256r * cr - a256i * ci + e.x, ni = a256r * ci + a256i * cr + e.y; cr = nr; ci = ni; }
      float gr = cr, gi = ci;
#pragma unroll
      for (int j = 0; j < 32; ++j) { const float xr = (j ? ser[j - 1] : 0.f) + gr, xi = (j ? sei[j - 1] : 0.f) + gi;
          *(LAS unsigned*)(SB + j * MAT_PITCH + 4 * lane) = pk2(xr, xi);
          const float tr = a8r * gr - a8i * gi, ti = a8r * gi + a8i * gr; gr = tr; gi = ti; } }
    LDS_WAIT(); __syncthreads();
    { bf16x8 Sf[2][4];
#pragma unroll
      for (int nt = 0; nt < 2; ++nt)
#pragma unroll
          for (int kk = 0; kk < 4; ++kk) Sf[nt][kk] = *(const LAS bf16x8*)(SB + (16 * nt + fr) * MAT_PITCH + (32 * kk + 8 * kq) * 2);
#pragma unroll
      for (int mt = 0; mt < 8; ++mt) { f32x4 y0 = (f32x4){0.f, 0.f, 0.f, 0.f}, y1 = (f32x4){0.f, 0.f, 0.f, 0.f};
#pragma unroll
          for (int kk = 0; kk <= mt / 2; ++kk) { const bf16x8 Af = *(const LAS bf16x8*)(R2 + (16 * mt + fr) * MAT_PITCH + (32 * kk + 8 * kq) * 2);
              y0 = __builtin_amdgcn_mfma_f32_16x16x32_bf16(Af, __builtin_bit_cast(bf16x8, Uw[0][kk]), y0, 0, 0, 0); y1 = __builtin_amdgcn_mfma_f32_16x16x32_bf16(Af, __builtin_bit_cast(bf16x8, Uw[1][kk]), y1, 0, 0, 0); }
#pragma unroll
          for (int kk = 0; kk < 4; ++kk) { const bf16x8 Af = *(const LAS bf16x8*)(R1 + (16 * mt + fr) * MAT_PITCH + (32 * kk + 8 * kq) * 2);
              y0 = __builtin_amdgcn_mfma_f32_16x16x32_bf16(Af, Sf[0][kk], y0, 0, 0, 0); y1 = __builtin_amdgcn_mfma_f32_16x16x32_bf16(Af, Sf[1][kk], y1, 0, 0, 0); }
          { v2u o; o.x = pk2(gelu_tanh(y0[0]), gelu_tanh(y0[1])); o.y = pk2(gelu_tanh(y0[2]), gelu_tanh(y0[3]));
            *(v2u*)((char*)Zb + ((tokw + 8 * fr + mt) * SSMW + g * CH + 4 * kq) * 2u) = o; }
          { v2u o; o.x = pk2(gelu_tanh(y1[0]), gelu_tanh(y1[1])); o.y = pk2(gelu_tanh(y1[2]), gelu_tanh(y1[3]));
            *(v2u*)((char*)Zb + ((tokw + 8 * (16 + fr) + mt) * SSMW + g * CH + 4 * kq) * 2u) = o; } } }
    LDS_WAIT(); __syncthreads();
}

__device__ __forceinline__ void p_conv(Frame& F, int l, int c0, int cs) {
    const int tid = F.tid; const unsigned c2 = 2 * tid;
    const bf16* HC = wsb(F, WS_HC); bf16* MIX = wsb(F, WS_MIX);
    LAS float* P = (LAS float*)F.lds;
    LAS float* ST = (LAS float*)(F.lds + 65536);
    f32x2 wt[CONV_K];
    { const float* wdw = inp(F, I_WDW) + (size_t)l * CONV_K * CONVW + c2;
#pragma unroll
      for (int j = 0; j < CONV_K; ++j) wt[j] = *(const f32x2*)(wdw + (size_t)j * CONVW); }
    const f32x2 bdw = *(const f32x2*)(inp(F, I_BDW) + (size_t)l * CONVW + c2);
    const f32x2 gg = *(const f32x2*)(inp(F, I_CLNG) + (size_t)l * CONVW + c2), bb = *(const f32x2*)(inp(F, I_CLNB) + (size_t)l * CONVW + c2);
#pragma unroll 1
    for (int item = c0; item < NTOK / 16; item += cs) {
        const int tok0 = item * 16, ts0 = tok0 & (SEQ - 1);
        unsigned win[46];
#pragma unroll
        for (int r = 0; r < 46; ++r) { const int tt = ts0 - 30 + r; win[r] = 0u; if (tt >= 0) win[r] = *(const unsigned*)((const char*)HC + ((unsigned)(tok0 - 30 + r) * CONVW + c2) * 2u); }
        f32x2 xw[46];
#pragma unroll
        for (int r = 0; r < 46; ++r) xw[r] = (f32x2){bflo(win[r]), bfhi(win[r])};
        f32x2 av[16];
#pragma unroll
        for (int i = 0; i < 16; ++i) av[i] = bdw;
#pragma unroll
        for (int j = 0; j < CONV_K; ++j) {
#pragma unroll
            for (int i = 0; i < 16; ++i) av[i] = __builtin_elementwise_fma(wt[j], xw[i + j], av[i]); }
        float a0[16], a1[16];
#pragma unroll
        for (int i = 0; i < 16; ++i) { a0[i] = av[i].x; a1[i] = av[i].y; }
#pragma unroll
        for (int i = 0; i < 16; ++i) { P[(2 * i) * 512 + tid] = a0[i] + a1[i]; P[(2 * i + 1) * 512 + tid] = a0[i] * a0[i] + a1[i] * a1[i]; }
        LDS_WAIT(); __syncthreads();
        { const int v = tid >> 4, sub = tid & 15; float sacc = 0.f;
#pragma unroll 8
          for (int q = 0; q < 32; ++q) sacc += P[v * 512 + sub + 16 * q];
          sacc += swz_xor<8>(sacc); sacc += swz_xor<4>(sacc); sacc += swz_xor<2>(sacc); sacc += swz_xor<1>(sacc);
          if (sub == 0) ST[v] = sacc; }
        LDS_WAIT(); __syncthreads();
#pragma unroll
        for (int i = 0; i < 16; ++i) { const float mean = ST[2 * i] * (1.f / CONVW); const float var = ST[2 * i + 1] * (1.f / CONVW) - mean * mean; const float rstd = rsqrtf(fmaxf(var, 0.f) + LN_EPS);
            const float o0 = silu_f((a0[i] - mean) * rstd * gg.x + bb.x), o1 = silu_f((a1[i] - mean) * rstd * gg.y + bb.y);
            *(unsigned*)((char*)MIX + ((unsigned)(tok0 + i) * D_MODEL + SSMW + c2) * 2u) = pk2(o0, o1); }
        __syncthreads();
    }
}

__device__ __forceinline__ void ln_row(float (&x)[4][8], const float* g, const float* b, int lane) {
    float s = 0.f;
#pragma unroll
    for (int j = 0; j < 4; ++j)
#pragma unroll
        for (int i = 0; i < 8; ++i) s += x[j][i];
    const float mean = wave_sum(s) * (1.f / D_MODEL); float q = 0.f;
#pragma unroll
    for (int j = 0; j < 4; ++j)
#pragma unroll
        for (int i = 0; i < 8; ++i) { x[j][i] -= mean; q += x[j][i] * x[j][i]; }
    const float rstd = rsqrtf(wave_sum(q) * (1.f / D_MODEL) + LN_EPS);
#pragma unroll
    for (int j = 0; j < 4; ++j) { const f32x4 g0 = *(const f32x4*)(g + 8 * lane + 512 * j), g1 = *(const f32x4*)(g + 8 * lane + 512 * j + 4), b0 = *(const f32x4*)(b + 8 * lane + 512 * j), b1 = *(const f32x4*)(b + 8 * lane + 512 * j + 4);
#pragma unroll
        for (int i = 0; i < 4; ++i) { x[j][i] = x[j][i] * rstd * g0[i] + b0[i]; x[j][4 + i] = x[j][4 + i] * rstd * g1[i] + b1[i]; } }
}
__device__ __forceinline__ void load_row_f32(const float* p, float (&x)[4][8], int lane) {
#pragma unroll
    for (int j = 0; j < 4; ++j) { const f32x4 a = *(const f32x4*)(p + 8 * lane + 512 * j), b = *(const f32x4*)(p + 8 * lane + 512 * j + 4);
#pragma unroll
        for (int i = 0; i < 4; ++i) { x[j][i] = a[i]; x[j][4 + i] = b[i]; } }
}

constexpr int HR_PITCH = 4112;
__device__ __forceinline__ void p_ln1_router(Frame& F, int l) {
    const int lane = F.lane, w = F.wave, tid = F.tid;
    LAS unsigned char* Hrow = F.lds;
    LAS float* Part = (LAS float*)(F.lds + 65792);
    LAS float* Lg = (LAS float*)(F.lds + 65792 + 24576);
    bf16* H1 = wsb(F, WS_H1);
    const float* V = (const float*)wsp(F, WS_V);
    const int fr = lane & 15, kq = lane >> 4;
    v4u Bw[8][3];
    { const bf16* Wr = wlayer(F, l, WO_R);
#pragma unroll
      for (int ks = 0; ks < 8; ++ks)
#pragma unroll
          for (int nt = 0; nt < 3; ++nt) Bw[ks][nt] = *(const v4u*)((const char*)Wr + ((unsigned)(16 * nt + fr) * D_MODEL + 256 * w + 32 * ks + 8 * kq) * 2u); }
    const float* lng = inp(F, I_LN1G) + (size_t)l * D_MODEL; const float* lnb = inp(F, I_LN1B) + (size_t)l * D_MODEL;
#pragma unroll 1
    for (int item = F.blk; item < NTOK / 16; item += F.G) {
        float x0[4][8], x1[4][8];
        const unsigned row0 = (unsigned)item * 16 + 2 * w;
        load_row_f32(V + (size_t)row0 * D_MODEL, x0, lane); load_row_f32(V + (size_t)(row0 + 1) * D_MODEL, x1, lane);
        ln_row(x0, lng, lnb, lane); ln_row(x1, lng, lnb, lane);
#pragma unroll
        for (int j = 0; j < 4; ++j) { const v4u p0 = pack8(x0[j]), p1 = pack8(x1[j]);
            *(v4u*)((char*)H1 + ((row0) * D_MODEL + 8 * lane + 512 * j) * 2u) = p0; *(v4u*)((char*)H1 + ((row0 + 1) * D_MODEL + 8 * lane + 512 * j) * 2u) = p1;
            *(LAS v4u*)(Hrow + (2 * w) * HR_PITCH + (8 * lane + 512 * j) * 2) = p0; *(LAS v4u*)(Hrow + (2 * w + 1) * HR_PITCH + (8 * lane + 512 * j) * 2) = p1; }
        LDS_WAIT(); __syncthreads();
        { f32x4 acc[3]; acc[0] = acc[1] = acc[2] = (f32x4){0.f, 0.f, 0.f, 0.f};
#pragma unroll
          for (int ks = 0; ks < 8; ++ks) { const int kb = 256 * w + 32 * ks + 8 * kq;
              const bf16x8 Af = *(const LAS bf16x8*)(Hrow + fr * HR_PITCH + kb * 2);
#pragma unroll
              for (int nt = 0; nt < 3; ++nt) acc[nt] = __builtin_amdgcn_mfma_f32_16x16x32_bf16(Af, __builtin_bit_cast(bf16x8, Bw[ks][nt]), acc[nt], 0, 0, 0); }
#pragma unroll
          for (int nt = 0; nt < 3; ++nt)
#pragma unroll
              for (int r = 0; r < 4; ++r) Part[(w * 16 + 4 * kq + r) * 48 + 16 * nt + fr] = acc[nt][r]; }
        LDS_WAIT(); __syncthreads();
        for (int o = tid; o < 16 * 48; o += NWAVES * 64) { float sacc = 0.f;
#pragma unroll
            for (int ww = 0; ww < 8; ++ww) sacc += Part[ww * 768 + o];
            const int n = o % 48; if (n < NEG) sacc += inp(F, I_BRG)[l * NEG + n]; else if (n < NEG + NEXP) sacc += inp(F, I_BRE2)[l * NEXP + n - NEG];
            Lg[o] = sacc; }
        LDS_WAIT(); __syncthreads();
        if (tid < 16) { const LAS float* lg = Lg + tid * 48; const int tokn = item * 16 + tid;
            int gi = 0; float gm = lg[0];
#pragma unroll
            for (int i = 1; i < NEG; ++i) if (lg[i] > gm) { gm = lg[i]; gi = i; }
            float gs = 0.f;
#pragma unroll
            for (int i = 0; i < NEG; ++i) gs += __expf(lg[i] - gm);
            const float gp = 1.f / gs;
            const LAS float* el = lg + NEG + EPG * gi;
            int i0 = 0; float v0 = el[0];
#pragma unroll
            for (int i = 1; i < EPG; ++i) if (el[i] > v0) { v0 = el[i]; i0 = i; }
            int i1 = -1; float v1 = -3.0e38f;
#pragma unroll
            for (int i = 0; i < EPG; ++i) if (i != i0 && el[i] > v1) { v1 = el[i]; i1 = i; }
            const float ex = __expf(v1 - v0), w0 = gp / (1.f + ex), w1 = gp * ex / (1.f + ex);
            const int e0 = gi * EPG + i0, e1 = gi * EPG + i1;
            unsigned* cnt = ctlw(F) + CW_CNT + l * NEXP * 16;
            const unsigned p0 = atomicAdd(cnt + e0 * 16, 1u), p1 = atomicAdd(cnt + e1 * 16, 1u);
            int* tk = (int*)wsp(F, WS_TOK); float* tw = (float*)wsp(F, WS_TOK + 256 * 1024);
            tk[tokn * 4 + 0] = e0; tk[tokn * 4 + 1] = e1; tk[tokn * 4 + 2] = (int)p0; tk[tokn * 4 + 3] = (int)p1; tw[tokn * 2 + 0] = w0; tw[tokn * 2 + 1] = w1; }
        __syncthreads();
    }
}

__device__ __forceinline__ void p_gather(Frame& F, int l) {
    LAS int* off = (LAS int*)F.lds;
    const unsigned* cnt = ctlw(F) + CW_CNT + l * NEXP * 16;
    if (F.tid == 0) { int tb = 0; int* te = (int*)(ctlw(F) + CW_TE + l * 128);
#pragma unroll 1
        for (int e = 0; e < NEXP; ++e) { const int c = (int)cnt[e * 16], nt = (c + 255) >> 8; off[e] = tb * 256;
            if (F.blk == 0) {
#pragma unroll 1
                for (int t = 0; t < nt; ++t) te[tb + t] = e; }
            tb += nt; }
        if (F.blk == 0) *(int*)(ctlw(F) + CW_NT + 64 * l) = tb; }
    LDS_WAIT(); __syncthreads();
    const int* tk = (const int*)(wsp(F, WS_TOK)); const float* tw = (const float*)(wsp(F, WS_TOK + 256 * 1024));
    int* tslot = (int*)(wsp(F, WS_TOK + 512 * 1024)); float* roww = (float*)(wsp(F, WS_ROWW));
    const bf16* H1 = wsb(F, WS_H1); bf16* XS = wsb(F, WS_XS);
    for (int pr = F.blk * NWAVES + F.wave; pr < NTOK * 2; pr += F.G * NWAVES) { const int t = pr >> 1, k = pr & 1;
        const int e = tk[t * 4 + k], pos = tk[t * 4 + 2 + k]; const int slot = off[e] + pos;
        const v4u* s = (const v4u*)(H1 + (size_t)t * D_MODEL); v4u* d = (v4u*)(XS + (size_t)slot * D_MODEL);
#pragma unroll
        for (int j = 0; j < 4; ++j) d[F.lane + 64 * j] = s[F.lane + 64 * j];
        if (F.lane == 0) { roww[slot] = tw[t * 2 + k]; tslot[pr] = slot; } }
    __syncthreads();
}

__device__ __forceinline__ void p_ln2(Frame& F, int l) {
    const bf16* H1 = wsb(F, WS_H1); const bf16* OS = wsb(F, WS_XS); bf16* H2 = wsb(F, WS_H2);
    const int* tslot = (const int*)(wsp(F, WS_TOK + 512 * 1024));
    for (int row = F.blk * NWAVES + F.wave; row < NTOK; row += F.G * NWAVES) { const int s0 = tslot[2 * row], s1 = tslot[2 * row + 1];
        float x[4][8];
#pragma unroll
        for (int j = 0; j < 4; ++j) { float a[8], b[8], c[8]; unpack8(*(const v4u*)(H1 + (size_t)row * D_MODEL + 8 * F.lane + 512 * j), a);
            unpack8(*(const v4u*)(OS + (size_t)s0 * D_MODEL + 8 * F.lane + 512 * j), b); unpack8(*(const v4u*)(OS + (size_t)s1 * D_MODEL + 8 * F.lane + 512 * j), c);
#pragma unroll
            for (int i = 0; i < 8; ++i) x[j][i] = ALPHA * a[i] + (b[i] + c[i]); }
        ln_row(x, inp(F, I_LN2G) + (size_t)l * D_MODEL, inp(F, I_LN2B) + (size_t)l * D_MODEL, F.lane);
#pragma unroll
        for (int j = 0; j < 4; ++j) *(v4u*)(H2 + (size_t)row * D_MODEL + 8 * F.lane + 512 * j) = pack8(x[j]); }
}
__device__ __forceinline__ void p_ln3(Frame& F, int l) {
    const float* V = (const float*)(wsp(F, WS_V)); bf16* XB = wsb(F, WS_XB);
    for (int row = F.blk * NWAVES + F.wave; row < NTOK; row += F.G * NWAVES) {
        float x[4][8]; load_row_f32(V + (size_t)row * D_MODEL, x, F.lane);
        ln_row(x, inp(F, I_LN3G) + (size_t)l * D_MODEL, inp(F, I_LN3B) + (size_t)l * D_MODEL, F.lane);
        if (l == DEPTH - 1) {
#pragma unroll
            for (int j = 0; j < 4; ++j) { *(f32x4*)(F.out + (size_t)row * D_MODEL + 8 * F.lane + 512 * j) = (f32x4){x[j][0], x[j][1], x[j][2], x[j][3]}; *(f32x4*)(F.out + (size_t)row * D_MODEL + 8 * F.lane + 512 * j + 4) = (f32x4){x[j][4], x[j][5], x[j][6], x[j][7]}; }
        } else {
#pragma unroll
            for (int j = 0; j < 4; ++j) *(v4u*)(XB + (size_t)row * D_MODEL + 8 * F.lane + 512 * j) = pack8(x[j]);
        }
    }
}

__global__ void __launch_bounds__(NWAVES * 64, 2) mk_fwd(Args args) {
    extern __shared__ __attribute__((aligned(16))) unsigned char lds[];
    Frame F;
    F.lds = (LAS unsigned char*)lds;
    F.tid = threadIdx.x; F.lane = F.tid & 63; F.wave = __builtin_amdgcn_readfirstlane(F.tid >> 6);
    const int wave0 = F.wave;
    F.blk = blockIdx.x; F.G = gridDim.x; F.z = 0; F.in = args.in; F.out = args.out; F.ws = args.ws;
    volatile LAS unsigned* MISC = (volatile LAS unsigned*)(F.lds + MISC_OFF);
    if (F.tid < 64) MISC[F.tid] = 0u;
    __syncthreads();
    const int lo = args.ph_lo, hi = args.ph_hi;
    XcdBarrier bar; bar.bar = (unsigned*)(args.ws + WS_CTL) + CW_BAR; bar.x = 0; bar.st = nullptr;
    if (hi - lo > 1) bar = xcd_barrier_post((unsigned*)(args.ws + WS_CTL) + CW_BAR, MISC + 8);
#define IN(k) (lo <= (k) && (k) < hi)
#define FRESH() do { int z_ = 0, g_ = gridDim.x, b_ = blockIdx.x, w_ = wave0; asm volatile("" : "+s"(z_), "+s"(g_), "+s"(b_), "+s"(w_)); \
    int l_ = (int)__builtin_amdgcn_mbcnt_hi(~0u, __builtin_amdgcn_mbcnt_lo(~0u, (unsigned)z_));   \
    F.z = z_; F.G = g_; F.blk = b_; F.wave = w_; F.lane = l_; F.tid = w_ * 64 + l_; } while (0)
#define SEAM(k) do { if (IN(k) && IN((k) + 1)) { int z_ = 0; asm volatile("" : "+s"(z_)); XcdBarrier bb_ = bar; bb_.bar = bar.bar + z_; bb_.x = bar.x + (unsigned)z_; xcd_barrier(bb_); } } while (0)
    LAS unsigned char* ring = F.lds;

    if (IN(0)) { FRESH(); p_prologue(F); SEAM(0); }

#pragma unroll 1
    for (int l = 0; l < DEPTH; ++l) {
        const int pb = 1 + PH_PER_LAYER * l;
        if (IN(pb + 0)) { FRESH();
            { pg8::Gemm g{wsb(F, WS_XB), wlayer(F, l, WO_IN), NTOK, INW, D_MODEL}; pg8::StaticOrder S; S.init(NTOK, INW, F.G, F.blk);
              EpiIn E{wsb(F, WS_U), wsb(F, WS_HC), inp(F, I_BIN) + (size_t)l * INW};
              pg8::gemm_phase<EpiIn, pg8::StaticOrder, true, true>(ring, g, S, E, F.tid); }
            { const int nfull = (NTOK / 256) * (INW / 256) - F.G;
              const bool spare = nfull > 0 && nfull < F.G;
              pg8::Gemm g{wsb(F, WS_PB) + (size_t)l * NTOK * PLE, wlayer(F, l, WO_P), NTOK, D_MODEL, PLE}; pg8::StaticOrder S;
              S.init(NTOK, D_MODEL, spare ? F.G - nfull : F.G, spare ? (F.blk >= nfull ? F.blk - nfull : (1 << 28)) : F.blk);
              EpiPlain E{wsb(F, WS_E1), D_MODEL};
              pg8::gemm_phase<EpiPlain, pg8::StaticOrder, true, true>(ring, g, S, E, F.tid); }
            SEAM(pb + 0);
        }
        if (IN(pb + 1)) { FRESH();
            for (int it = F.blk; it < BATCH * NGRP; it += F.G) scan_item(F, l, it);
            SEAM(pb + 1);
        }
        if (IN(pb + 2)) { FRESH();
            const bool split = F.G > 128;
            if (!split || F.blk < 128) {
                pg8::Gemm g{wsb(F, WS_Z), wlayer(F, l, WO_GLU), NTOK, SSMW, SSMW}; pg8::StaticOrder S; S.init(NTOK, SSMW, split ? 128 : F.G, F.blk);
                EpiGlu E{wsb(F, WS_Z), wsb(F, WS_MIX), inp(F, I_BGLU) + (size_t)l * SSMW};
                pg8::gemm_phase<EpiGlu, pg8::StaticOrder, true, true>(ring, g, S, E, F.tid); }
            if (!split || F.blk >= 128) {
                const int c0 = split ? F.blk - 128 : F.blk, cs = split ? F.G - 128 : F.G;
                p_conv(F, l, c0, cs); }
            SEAM(pb + 2);
        }
        if (IN(pb + 3)) { FRESH();
            pg8::Gemm g{wsb(F, WS_MIX), wlayer(F, l, WO_O), NTOK, D_MODEL, D_MODEL}; pg8::StaticOrder S; S.init(NTOK, D_MODEL, F.G, F.blk);
            EpiOut E{wsb(F, WS_XB), (float*)(wsp(F, WS_V)), inp(F, I_BO) + (size_t)l * D_MODEL};
            pg8::gemm_phase<EpiOut, pg8::StaticOrder, true, true>(ring, g, S, E, F.tid);
            SEAM(pb + 3);
        }
        if (IN(pb + 4)) { FRESH();
            p_ln1_router(F, l);
            SEAM(pb + 4);
        }
        if (IN(pb + 5)) { FRESH(); p_gather(F, l); SEAM(pb + 5); }
        if (IN(pb + 6)) { FRESH();
            const int ntl = *(const int*)(ctlw(F) + CW_NT + 64 * l);
            pg8::Gemm g{wsb(F, WS_XS), wlayer(F, l, WO_GU), SROWS, NEXP * 512, D_MODEL};
            pg8::MoeOrder S{(const int*)(ctlw(F) + CW_TE + l * 128), ntl, 2, F.G, F.blk};
            EpiMoeUp E{wsb(F, WS_HS), (const float*)wsp(F, WS_ROWW)};
            pg8::gemm_phase<EpiMoeUp, pg8::MoeOrder, true, true>(ring, g, S, E, F.tid);
            SEAM(pb + 6);
        }
        if (IN(pb + 7)) { FRESH();
            const int ntl = *(const int*)(ctlw(F) + CW_NT + 64 * l);
            pg8::Gemm g{wsb(F, WS_HS), wlayer(F, l, WO_D), SROWS, NEXP * D_MODEL, EH};
            pg8::MoeOrder S{(const int*)(ctlw(F) + CW_TE + l * 128), ntl, 8, F.G, F.blk};
            EpiPlain E{wsb(F, WS_XS), D_MODEL};
            pg8::gemm_phase<EpiPlain, pg8::MoeOrder, true, true>(ring, g, S, E, F.tid);
            SEAM(pb + 7);
        }
        if (IN(pb + 8)) { FRESH(); p_ln2(F, l); SEAM(pb + 8); }
        if (IN(pb + 9)) { FRESH();
            pg8::Gemm g{wsb(F, WS_H2), wlayer(F, l, WO_PG), NTOK, D_MODEL, D_MODEL}; pg8::StaticOrder S; S.init(NTOK, D_MODEL, F.G, F.blk);
            EpiGate E{wsb(F, WS_H2), wsb(F, WS_E1), (float*)(wsp(F, WS_V)), inp(F, I_BPG) + (size_t)l * D_MODEL};
            pg8::gemm_phase<EpiGate, pg8::StaticOrder, true, true>(ring, g, S, E, F.tid);
            SEAM(pb + 9);
        }
        if (IN(pb + 10)) { FRESH(); p_ln3(F, l); SEAM(pb + 10); }
    }
#undef IN
#undef SEAM
}

extern "C" void kernel_launch(void* const* d_in, const int* in_sizes, int n_in, void* d_out, int out_size, void* d_ws, size_t ws_size, hipStream_t stream) {
    static int grid = 0;
    if (grid == 0) {
        if (n_in != 36 || in_sizes[0] != NTOK * D_MODEL || out_size != NTOK * D_MODEL || ws_size < WS_END) { fprintf(stderr, "kernel_launch: unexpected shapes (n_in %d, in0 %d, out %d, ws %zu < %zu)\n", n_in, n_in > 0 ? in_sizes[0] : -1, out_size, ws_size, (size_t)WS_END); grid = -1; return; }
        int dev = 0, cus = 0, per_cu = 0;
        if (hipGetDevice(&dev) != hipSuccess || hipDeviceGetAttribute(&cus, hipDeviceAttributeMultiprocessorCount, dev) != hipSuccess) { grid = -1; return; }
        if (hipFuncSetAttribute((const void*)mk_fwd, hipFuncAttributeMaxDynamicSharedMemorySize, LDS_BYTES) != hipSuccess) { fprintf(stderr, "kernel_launch: hipFuncSetAttribute failed\n"); grid = -1; return; }
        if (hipOccupancyMaxActiveBlocksPerMultiprocessor(&per_cu, (const void*)mk_fwd, NWAVES * 64, LDS_BYTES) != hipSuccess || per_cu < 1) fprintf(stderr, "kernel_launch: occupancy query reports %d\n", per_cu);
        (void)hipGetLastError();
        grid = cus;
    }
    if (grid < 0) return;
    if (hipMemsetAsync((char*)d_ws + WS_CTL, 0, CTL_ZERO_BYTES, stream) != hipSuccess) return;
    Args a{};
    for (int i = 0; i < 36; ++i) a.in[i] = (const float*)d_in[i];
    a.out = (float*)d_out; a.ws = (unsigned char*)d_ws;
#if MK_SINGLE
    a.ph_lo = 0; a.ph_hi = NPHASES;
    hipLaunchKernelGGL(mk_fwd, dim3(grid), dim3(NWAVES * 64), LDS_BYTES, stream, a);
#else
    for (int ph = 0; ph < NPHASES; ++ph) { a.ph_lo = ph; a.ph_hi = ph + 1;
        hipLaunchKernelGGL(mk_fwd, dim3(grid), dim3(NWAVES * 64), LDS_BYTES, stream, a);
        const int pil = ph == 0 ? 0 : 1 + (ph - 1) % PH_PER_LAYER;
        if (pil == PROBE_DUP) {
            if (pil == 5) hipMemsetAsync((char*)d_ws + WS_CTL + CW_CNT * 4, 0, DEPTH * NEXP * 16 * 4, stream);
            hipLaunchKernelGGL(mk_fwd, dim3(grid), dim3(NWAVES * 64), LDS_BYTES, stream, a); } }
#endif
}
```
